# Optimizing an MI355X kernel written in HIP

```python
import math, functools
import jax, jax.numpy as jnp
from jax import lax
import numpy as np

D_MODEL = 1024
BATCH = 4
SEQ = 4096
DEPTH = 4
DEC_BATCH = 32
DEC_SEQ = 1
PAST_LEN = 8192
PAGE_SIZE = 128

POOL_WIDTH = D_MODEL // 2
POOL_WINDOWS = (2, 4, 8, 16)
N_POOL_GROUPS = len(POOL_WINDOWS)
POOL_GROUP = POOL_WIDTH // N_POOL_GROUPS
POOL_HIST = max(POOL_WINDOWS) - 1
HEAD_DIM = 64
ATTN_PATTERNS = ((128, 1), (512, 4), (2048, 16))
N_GROUPS = len(ATTN_PATTERNS)
HEADS_PER_GROUP = 4
N_HEADS = N_GROUPS * HEADS_PER_GROUP
ATTN_WIDTH = N_HEADS * HEAD_DIM
ATTN_OUT = HEADS_PER_GROUP * HEAD_DIM
N_KEYS = 128
BLK = 128
D_FF = 4 * D_MODEL
ROPE_THETA = 10000.0
EPS = 1e-6
IN_SPLITS = [POOL_WIDTH, POOL_WIDTH + ATTN_WIDTH, POOL_WIDTH + 2 * ATTN_WIDTH,
             POOL_WIDTH + 3 * ATTN_WIDTH, POOL_WIDTH + 3 * ATTN_WIDTH + D_MODEL]
IN_WIDTH = POOL_WIDTH + 3 * ATTN_WIDTH + 2 * D_MODEL

kernel_name = 'hybrid_pool_dilated_attn_decoder_step'


def rmsnorm(x, gain):
    xf = x.astype(jnp.float32)
    y = xf * lax.rsqrt(jnp.mean(xf * xf, axis=-1, keepdims=True) + EPS)
    return (y * gain.astype(jnp.float32)).astype(x.dtype)


def modulate(x, gain, shift, scale):
    return rmsnorm(x, gain) * (1 + scale) + shift


def rope(x, pos):
    inv_freq = ROPE_THETA ** (-jnp.arange(0, HEAD_DIM, 2, dtype=jnp.float32) / HEAD_DIM)
    ang = pos[:, None] * inv_freq[None, :]
    cos = jnp.cos(ang)[None, :, None, :]
    sin = jnp.sin(ang)[None, :, None, :]
    xf = x.astype(jnp.float32)
    x1, x2 = xf[..., :HEAD_DIM // 2], xf[..., HEAD_DIM // 2:]
    return jnp.concatenate([x1 * cos - x2 * sin, x2 * cos + x1 * sin], axis=-1).astype(x.dtype)


def project_inputs(h, pos, w_in, q_norm_g, k_norm_g):
    b, l = h.shape[0], h.shape[1]
    z = h @ w_in
    u, q, k, v, a_pool, a_attn = jnp.split(z, IN_SPLITS, axis=-1)
    q = rope(rmsnorm(q.reshape(b, l, N_HEADS, HEAD_DIM), q_norm_g), pos)
    k = rope(rmsnorm(k.reshape(b, l, N_HEADS, HEAD_DIM), k_norm_g), pos)
    v = v.reshape(b, l, N_HEADS, HEAD_DIM)
    return u, q, k, v, a_pool, a_attn


def pool_mix(ext, pos, w_pool_grp, pool_scale):
    b = ext.shape[0]
    l = ext.shape[1] - POOL_HIST
    ef = ext.astype(jnp.float32)
    cs = jnp.concatenate([jnp.zeros((b, 1, POOL_WIDTH), jnp.float32), jnp.cumsum(ef, axis=1)], axis=1)
    u = ef[:, POOL_HIST:]
    outs = []
    for gi, w in enumerate(POOL_WINDOWS):
        sl = slice(gi * POOL_GROUP, (gi + 1) * POOL_GROUP)
        wsum = cs[:, POOL_HIST + 1:POOL_HIST + 1 + l, sl] - cs[:, POOL_HIST + 1 - w:POOL_HIST + 1 - w + l, sl]
        cnt = jnp.minimum(pos + 1.0, float(w))[None, :, None]
        outs.append(wsum / cnt - u[..., sl])
    p = jnp.stack(outs, axis=2)
    y = jnp.einsum('blgc,gce->blge', p, w_pool_grp.astype(jnp.float32)).reshape(b, l, POOL_WIDTH)
    return (y * pool_scale.astype(jnp.float32)).astype(ext.dtype)


def band_dilated_attn(q, k, v, dil):
    b, s, h, dh = q.shape
    span = dil * BLK
    sp = -(-s // span) * span
    nb = sp // span

    def to_blocks(t):
        t = jnp.pad(t.astype(jnp.float32), ((0, 0), (0, sp - s), (0, 0), (0, 0)))
        t = jnp.moveaxis(t.reshape(b, sp // dil, dil, h, dh), 2, 1)
        return t.reshape(b, dil, nb, BLK, h, dh)

    def with_prev(t):
        prev = jnp.concatenate([jnp.zeros_like(t[:, :, :1]), t[:, :, :-1]], axis=2)
        return jnp.concatenate([prev, t], axis=3)

    qb = to_blocks(q)
    kk = with_prev(to_blocks(k))
    vv = with_prev(to_blocks(v))
    sc = jnp.einsum('brnqhd,brnkhd->brnhqk', qb, kk) / math.sqrt(dh)
    qi = jnp.arange(BLK)[:, None]
    kj = jnp.arange(2 * BLK)[None, :]
    dist = BLK + qi - kj
    band = (dist >= 0) & (dist <= N_KEYS)
    exists = (jnp.arange(nb)[:, None, None] * BLK - BLK + kj[None] >= 0)
    mask = (band[None] & exists)[None, None, :, None]
    sc = jnp.where(mask, sc, -jnp.inf)
    m = jnp.max(sc, axis=-1, keepdims=True)
    p = jnp.exp(sc - m)
    den = jnp.sum(p, axis=-1)
    o = jnp.einsum('brnhqk,brnkhd->brnqhd', p, vv) / jnp.swapaxes(den, -1, -2)[..., None]
    lse = jnp.swapaxes(m[..., 0] + jnp.log(den), -1, -2)

    def from_blocks(t):
        rest = t.shape[4:]
        t = jnp.moveaxis(t.reshape((b, dil, nb * BLK) + rest), 1, 2)
        return t.reshape((b, sp) + rest)[:, :s]

    return from_blocks(o), from_blocks(lse)


def gathered_dilated_attn(q, k_ext, v_ext, dil, hist):
    t = q.shape[1]
    idx = hist + jnp.arange(t)[:, None] - dil * jnp.arange(N_KEYS + 1)[None, :]
    valid = idx >= 0
    idxc = jnp.maximum(idx, 0)
    kg = k_ext[:, idxc].astype(jnp.float32)
    vg = v_ext[:, idxc].astype(jnp.float32)
    sc = jnp.einsum('bthd,btkhd->bthk', q.astype(jnp.float32), kg) / math.sqrt(HEAD_DIM)
    sc = jnp.where(valid[None, :, None, :], sc, -jnp.inf)
    m = jnp.max(sc, axis=-1, keepdims=True)
    p = jnp.exp(sc - m)
    den = jnp.sum(p, axis=-1)
    o = jnp.einsum('bthk,btkhd->bthd', p, vg) / den[..., None]
    return o, m[..., 0] + jnp.log(den)


def prompt_attend(g, q, k, v):
    win, dil = ATTN_PATTERNS[g]
    o, lse = band_dilated_attn(q, k, v, dil)
    keep = min(win, k.shape[1])
    return o, lse, k[:, k.shape[1] - keep:], v[:, v.shape[1] - keep:]


def sample_attend(cache_ks, cache_vs, g, q, k, v):
    win, dil = ATTN_PATTERNS[g]
    ck, cv = cache_ks[g], cache_vs[g]
    k_ext = jnp.concatenate([ck, k.astype(ck.dtype)], axis=1)
    v_ext = jnp.concatenate([cv, v.astype(cv.dtype)], axis=1)
    o, lse = gathered_dilated_attn(q, k_ext, v_ext, dil, ck.shape[1])
    return o, lse, k, v


def combine_groups(outs, lses):
    w = jax.nn.softmax(jnp.stack(lses, axis=0), axis=0)
    o = jnp.sum(w[..., None] * jnp.stack(outs, axis=0), axis=0)
    return o.reshape(o.shape[0], o.shape[1], ATTN_OUT)


def trunk_layer(x, c, pos, pool_prev, attend, norm1_g, norm2_g, w_ada, b_ada, w_in, q_norm_g, k_norm_g,
                w_pool_grp, pool_scale, w_pool_br, w_attn_br, w_out, w_up, w_down):
    mod = (jax.nn.silu(c) @ w_ada + b_ada)[:, None, :]
    sh1, sc1, g1, sh2, sc2, g2 = jnp.split(mod, 6, axis=-1)
    h = modulate(x, norm1_g, sh1, sc1)
    u, q, k, v, a_pool, a_attn = project_inputs(h, pos, w_in, q_norm_g, k_norm_g)
    ext = jnp.concatenate([pool_prev.astype(u.dtype), u], axis=1)
    pool_y = pool_mix(ext, pos, w_pool_grp, pool_scale)
    outs, lses, rows = [], [], []
    for g in range(N_GROUPS):
        hs = slice(g * HEADS_PER_GROUP, (g + 1) * HEADS_PER_GROUP)
        o, lse, kr, vr = attend(g, q[:, :, hs], k[:, :, hs], v[:, :, hs])
        outs.append(o)
        lses.append(lse)
        rows.append((kr, vr))
    attn_y = combine_groups(outs, lses).astype(x.dtype)
    merged = jax.nn.sigmoid(a_pool) * (pool_y @ w_pool_br) + jax.nn.sigmoid(a_attn) * (attn_y @ w_attn_br)
    x = x + g1 * (merged @ w_out)
    h2 = modulate(x, norm2_g, sh2, sc2)
    x = x + g2 * (jnp.square(jax.nn.relu(h2 @ w_up)) @ w_down)
    return x, rows, ext[:, ext.shape[1] - POOL_HIST:]


def setup_inputs(seed: int = 0) -> dict:
    key = jax.random.key(seed)
    ks = jax.random.split(key, 32)
    nrm = jax.random.normal
    f32 = jnp.float32
    inp = {}
    inp['x_prompt'] = nrm(ks[0], (BATCH, SEQ, D_MODEL), f32)
    inp['x_sample'] = nrm(ks[1], (DEC_BATCH, DEC_SEQ, D_MODEL), f32)
    for i, (win, dil) in enumerate(ATTN_PATTERNS):
        buf = min(win, PAST_LEN)
        inp['cache_k_w%d' % win] = nrm(ks[2 + 2 * i], (DEPTH, DEC_BATCH, buf, HEADS_PER_GROUP, HEAD_DIM), f32)
        inp['cache_v_w%d' % win] = nrm(ks[3 + 2 * i], (DEPTH, DEC_BATCH, buf, HEADS_PER_GROUP, HEAD_DIM), f32)
    inp['state_pool'] = nrm(ks[8], (DEPTH, DEC_BATCH, POOL_HIST, POOL_WIDTH), f32)
    inp['c_prompt'] = nrm(ks[9], (BATCH, D_MODEL), f32)
    inp['c_sample'] = nrm(ks[10], (DEC_BATCH, D_MODEL), f32)
    inp['norm1_g'] = 1.0 + 0.02 * nrm(ks[11], (DEPTH, D_MODEL), f32)
    inp['norm2_g'] = 1.0 + 0.02 * nrm(ks[12], (DEPTH, D_MODEL), f32)
    inp['w_ada'] = 0.3 * D_MODEL ** -0.5 * nrm(ks[13], (DEPTH, D_MODEL, 6 * D_MODEL), f32)
    inp['b_ada'] = 0.02 * nrm(ks[14], (DEPTH, 6 * D_MODEL), f32)
    inp['w_in'] = D_MODEL ** -0.5 * nrm(ks[15], (DEPTH, D_MODEL, IN_WIDTH), f32)
    inp['q_norm_g'] = 1.0 + 0.02 * nrm(ks[16], (DEPTH, HEAD_DIM), f32)
    inp['k_norm_g'] = 1.0 + 0.02 * nrm(ks[17], (DEPTH, HEAD_DIM), f32)
    inp['w_pool_grp'] = POOL_GROUP ** -0.5 * nrm(ks[18], (DEPTH, N_POOL_GROUPS, POOL_GROUP, POOL_GROUP), f32)
    inp['pool_scale'] = 1.0 + 0.02 * nrm(ks[19], (DEPTH, POOL_WIDTH), f32)
    inp['w_pool_br'] = POOL_WIDTH ** -0.5 * nrm(ks[20], (DEPTH, POOL_WIDTH, D_MODEL), f32)
    inp['w_attn_br'] = ATTN_OUT ** -0.5 * nrm(ks[21], (DEPTH, ATTN_OUT, D_MODEL), f32)
    inp['w_out'] = D_MODEL ** -0.5 * nrm(ks[22], (DEPTH, D_MODEL, D_MODEL), f32)
    inp['w_up'] = D_MODEL ** -0.5 * nrm(ks[23], (DEPTH, D_MODEL, D_FF), f32)
    inp['w_down'] = D_FF ** -0.5 * nrm(ks[24], (DEPTH, D_FF, D_MODEL), f32)
    return inp


def reference(x_prompt, x_sample, cache_k_w128, cache_v_w128, cache_k_w512, cache_v_w512,
              cache_k_w2048, cache_v_w2048, state_pool, c_prompt, c_sample, norm1_g, norm2_g,
              w_ada, b_ada, w_in, q_norm_g, k_norm_g, w_pool_grp, pool_scale, w_pool_br,
              w_attn_br, w_out, w_up, w_down):
    pos_p = jnp.arange(x_prompt.shape[1], dtype=jnp.float32)
    pos_s = PAST_LEN + jnp.arange(x_sample.shape[1], dtype=jnp.float32)
    caches_k = (cache_k_w128, cache_k_w512, cache_k_w2048)
    caches_v = (cache_v_w128, cache_v_w512, cache_v_w2048)
    kp = [[] for _ in range(N_GROUPS)]
    vp = [[] for _ in range(N_GROUPS)]
    ks_ = [[] for _ in range(N_GROUPS)]
    vs_ = [[] for _ in range(N_GROUPS)]
    pool_p_rows, pool_s_rows = [], []
    xp, xs = x_prompt, x_sample
    for l in range(DEPTH):
        weights = (norm1_g[l], norm2_g[l], w_ada[l], b_ada[l], w_in[l], q_norm_g[l], k_norm_g[l],
                   w_pool_grp[l], pool_scale[l], w_pool_br[l], w_attn_br[l], w_out[l], w_up[l], w_down[l])
        pool0 = jnp.zeros((xp.shape[0], POOL_HIST, POOL_WIDTH), xp.dtype)
        xp, rows_p, pool_p = trunk_layer(xp, c_prompt, pos_p, pool0, prompt_attend, *weights)
        attend_s = functools.partial(sample_attend, tuple(ck[l] for ck in caches_k),
                                     tuple(cv[l] for cv in caches_v))
        xs, rows_s, pool_s = trunk_layer(xs, c_sample, pos_s, state_pool[l], attend_s, *weights)
        for g in range(N_GROUPS):
            kp[g].append(rows_p[g][0])
            vp[g].append(rows_p[g][1])
            ks_[g].append(rows_s[g][0])
            vs_[g].append(rows_s[g][1])
        pool_p_rows.append(pool_p)
        pool_s_rows.append(pool_s)
    new_k_w128_p, new_k_w512_p, new_k_w2048_p = [jnp.stack(r, axis=0) for r in kp]
    new_v_w128_p, new_v_w512_p, new_v_w2048_p = [jnp.stack(r, axis=0) for r in vp]
    new_k_w128_s, new_k_w512_s, new_k_w2048_s = [jnp.stack(r, axis=0) for r in ks_]
    new_v_w128_s, new_v_w512_s, new_v_w2048_s = [jnp.stack(r, axis=0) for r in vs_]
    new_pool_p = jnp.stack(pool_p_rows, axis=0)
    new_pool_s = jnp.stack(pool_s_rows, axis=0)
    return (xp, xs,
            new_k_w128_p, new_v_w128_p, new_k_w512_p, new_v_w512_p, new_k_w2048_p, new_v_w2048_p, new_pool_p,
            new_k_w128_s, new_v_w128_s, new_k_w512_s, new_v_w512_s, new_k_w2048_s, new_v_w2048_s, new_pool_s)
```

```cpp
#include <hip/hip_runtime.h>
#include <cstdio>
#include <cstdint>
namespace pg8 {
#define PG8_LAS __attribute__((address_space(3)))
typedef unsigned short bf16_t;
typedef short bf16x8 __attribute__((ext_vector_type(8)));
typedef float f32x4 __attribute__((ext_vector_type(4)));
typedef unsigned u32x4 __attribute__((ext_vector_type(4)));
constexpr int BM = 256, BK = 64, HALF = 128, HTB = HALF * BK * 2  , STAGE_BYTES = 8 * HTB, NXCD = 8, WGM = 8;

__host__ __device__ __forceinline__ int lds_byte(int r, int c) { const int st = (r >> 4) * 2 + (c >> 5), rr = r & 15, cc = c & 31, ob = rr * 64 + cc * 2; return st * 1024 + (ob ^ (((ob >> 9) & 1) << 5)); }
__host__ __device__ __forceinline__ void stage_rc(int b, int& R, int& C) { const int st = b / 1024, sb = b % 1024, swz = sb ^ (((sb >> 9) & 1) << 5); R = (st >> 1) * 16 + swz / 64; C = (st & 1) * 32 + (swz % 64) / 2; }
__host__ __device__ __forceinline__ int perm32(int rho) { const int n = rho >> 4, i = rho & 15; return 8 * (i >> 2) + 4 * n + (i & 3); }

struct Unit { int pm, pn; };
struct Gemm { const bf16_t* A; const bf16_t* Bt; int M, N, K, lda, ldb; };

struct StaticOrder {
    int nM, nN, nwg, G, c;
    __host__ __device__ void init(int M, int N, int G_, int c_) { nM = M / BM; nN = N / BM; nwg = nM * nN; G = G_; c = c_; }
    __host__ __device__ bool next(int i, Unit& u) const {
        const long L = (long)i * G + c; if (L >= nwg) return false;
        int wgid = (int)L; { const int q = nwg / NXCD, r = nwg % NXCD, xcd = wgid % NXCD, off = wgid / NXCD; wgid = (xcd < r ? xcd * (q + 1) : r * (q + 1) + (xcd - r) * q) + off; }
        const int nig = WGM * nN, gid = wgid / nig, fm = gid * WGM, gsz = (nM - fm) < WGM ? (nM - fm) : WGM;
        u.pm = fm + ((wgid % nig) % gsz); u.pn = (wgid % nig) / gsz; return true;
    }
    __device__ __forceinline__ void a_ready(const Unit&) const {}
    __device__ __forceinline__ void done(const Unit&) const {}
};

__device__ __forceinline__ unsigned cvt_pk_bf16(float lo, float hi) { unsigned r; asm volatile("v_cvt_pk_bf16_f32 %0, %1, %2" : "=v"(r) : "v"(lo), "v"(hi)); return r; }
typedef float f32x2 __attribute__((ext_vector_type(2)));
template <class Epi, class Sched, bool ALIGN_EPI = false, bool SP2 = false>
__device__ __forceinline__ void gemm_phase(PG8_LAS unsigned char* lds, const Gemm g, const Sched& S, const Epi& E) {
    int tid_ = threadIdx.x; asm volatile("" : "+v"(tid_));
    const int tid = tid_, wid = __builtin_amdgcn_readfirstlane(tid >> 6), lane = tid & 63, wr = wid >> 2, wc = wid & 3, fr = lane & 15, fq = lane >> 4;
    const int K = g.K, nt = K / BK;
    unsigned voffA[2], voffB[2];
#pragma unroll
    for (int i = 0; i < 2; ++i) { int R, C; stage_rc(tid * 16 + i * 8192, R, C); const int Rb = Epi::PERM ? ((R & ~31) + perm32(R & 31)) : R;
        voffA[i] = (unsigned)(R * g.lda + C) * 2u; voffB[i] = (unsigned)(Rb * g.ldb + C) * 2u; }
    const size_t kstep = (size_t)(BK * 2);
    const size_t hstepA = (size_t)HALF * g.lda * 2, hstepB = (size_t)HALF * g.ldb * 2;
    const size_t tstepA = 2 * hstepA, tstepB = 2 * hstepB;
    const unsigned ldsw = (unsigned)wid * 1024u;
    const int aoff = lds_byte(wr * 64 + fr, fq * 8), boff = lds_byte(wc * 32 + fr, fq * 8);
#define PG8_SA(b, h) (((b) * 2 + (h)) * HTB)
#define PG8_SB(b, h) ((4 + (b) * 2 + (h)) * HTB)
#define PG8_STAGE(bufoff, gbase, voff) do { _Pragma("unroll") for (int _i = 0; _i < 2; ++_i) \
        __builtin_amdgcn_global_load_lds((const unsigned*)((const char*)(gbase) + (voff)[_i]), (PG8_LAS unsigned*)(lds + (bufoff) + ldsw + _i * 8192), 16, 0, 0); } while (0)
#define PG8_LDA(dst, b, h) do { _Pragma("unroll") for (int m = 0; m < 4; ++m) _Pragma("unroll") for (int k = 0; k < 2; ++k) dst[m][k] = *(const PG8_LAS bf16x8*)(lds + PG8_SA(b, h) + aoff + m * 2048 + k * 1024); } while (0)
#define PG8_LDB(dst, b, h) do { _Pragma("unroll") for (int n = 0; n < 2; ++n) _Pragma("unroll") for (int k = 0; k < 2; ++k) dst[n][k] = *(const PG8_LAS bf16x8*)(lds + PG8_SB(b, h) + boff + n * 2048 + k * 1024); } while (0)
#define PG8_MMA(ai, bj, At, Bt) do { __builtin_amdgcn_s_setprio(1); _Pragma("unroll") for (int m = 0; m < 4; ++m) _Pragma("unroll") for (int n = 0; n < 2; ++n) _Pragma("unroll") for (int k = 0; k < 2; ++k) \
        acc[ai][bj][m][n] = __builtin_amdgcn_mfma_f32_16x16x32_bf16(Bt[n][k], At[m][k], acc[ai][bj][m][n], 0, 0, 0); __builtin_amdgcn_s_setprio(0); } while (0)
#define PG8_WAIT_V(n) asm volatile("s_waitcnt vmcnt(" #n ")" ::: "memory")
#define PG8_WAIT_L(n) asm volatile("s_waitcnt lgkmcnt(" #n ")" ::: "memory")
#define PG8_BAR __builtin_amdgcn_s_barrier()
#define PG8_SCHED __builtin_amdgcn_sched_barrier(0)
    Unit cur, nxt; int ui = 0;
    if (!S.next(0, cur)) return;
    f32x4 acc[2][2][4][2];
#pragma unroll
    for (int a = 0; a < 2; ++a)
#pragma unroll
        for (int b = 0; b < 2; ++b)
#pragma unroll
            for (int m = 0; m < 4; ++m)
#pragma unroll
                for (int n = 0; n < 2; ++n) acc[a][b][m][n] = (f32x4){0.f, 0.f, 0.f, 0.f};
    bf16x8 At[4][2], B0[2][2], B1[2][2];
    const char* cA = (const char*)g.A + (size_t)cur.pm * tstepA; const char* cB = (const char*)g.Bt + (size_t)cur.pn * tstepB;
    S.a_ready(cur);
    if constexpr (SP2) {
        PG8_STAGE(PG8_SB(0, 0), cB, voffB); PG8_STAGE(PG8_SB(0, 1), cB + hstepB, voffB); PG8_STAGE(PG8_SA(0, 0), cA, voffA); PG8_STAGE(PG8_SA(0, 1), cA + hstepA, voffA);
        if (wr == 1) PG8_BAR;
        PG8_WAIT_V(2); PG8_BAR;
        PG8_STAGE(PG8_SB(1, 0), cB + kstep, voffB); PG8_STAGE(PG8_SA(1, 0), cA + kstep, voffA); PG8_STAGE(PG8_SB(1, 1), cB + hstepB + kstep, voffB);
        PG8_WAIT_V(6); PG8_BAR;
    } else {
        PG8_STAGE(PG8_SB(0, 0), cB, voffB); PG8_STAGE(PG8_SA(0, 0), cA, voffA); PG8_STAGE(PG8_SB(0, 1), cB + hstepB, voffB); PG8_STAGE(PG8_SA(0, 1), cA + hstepA, voffA);
        if (wr == 1) PG8_BAR;
        PG8_WAIT_V(4); PG8_BAR;
        PG8_STAGE(PG8_SB(1, 0), cB + kstep, voffB); PG8_STAGE(PG8_SA(1, 0), cA + kstep, voffA); PG8_STAGE(PG8_SB(1, 1), cB + hstepB + kstep, voffB);
        PG8_WAIT_V(6); PG8_BAR;
    }
    for (;;) {
        const bool has_next = S.next(ui + 1, nxt);
        const char* nA = has_next ? (const char*)g.A + (size_t)nxt.pm * tstepA : cA; const char* nB = has_next ? (const char*)g.Bt + (size_t)nxt.pn * tstepB : cB;
        for (int t = 0; t < nt; t += 2) {
            const bool last = (t == nt - 2);
            const char* a1 = cA + (size_t)(t + 1) * kstep;
            const char* a2 = last ? nA : cA + (size_t)(t + 2) * kstep; const char* b2 = last ? nB : cB + (size_t)(t + 2) * kstep;
            const char* a3 = a2 + kstep; const char* b3 = b2 + kstep;
            if (last && has_next) S.a_ready(nxt);
            if constexpr (SP2) {
            PG8_LDB(B0, 0, 0); PG8_LDB(B1, 0, 1); PG8_SCHED; PG8_LDA(At, 0, 0); PG8_STAGE(PG8_SA(1, 1), a1 + hstepA, voffA);
            PG8_WAIT_V(8); PG8_WAIT_L(0); PG8_BAR; PG8_MMA(0, 0, At, B0); PG8_MMA(0, 1, At, B1); PG8_BAR; PG8_SCHED;
            PG8_LDA(At, 0, 1); PG8_STAGE(PG8_SB(0, 0), b2, voffB); PG8_STAGE(PG8_SB(0, 1), b2 + hstepB, voffB); PG8_STAGE(PG8_SA(0, 0), a2, voffA);
            PG8_WAIT_V(8); PG8_WAIT_L(0); PG8_BAR; PG8_MMA(1, 0, At, B0); PG8_MMA(1, 1, At, B1); PG8_BAR; PG8_SCHED;
            PG8_LDB(B0, 1, 0); PG8_LDB(B1, 1, 1); PG8_SCHED; PG8_LDA(At, 1, 0); PG8_STAGE(PG8_SA(0, 1), a2 + hstepA, voffA);
            PG8_WAIT_V(8); PG8_WAIT_L(0); PG8_BAR; PG8_MMA(0, 0, At, B0); PG8_MMA(0, 1, At, B1); PG8_BAR; PG8_SCHED;
            PG8_LDA(At, 1, 1); PG8_STAGE(PG8_SB(1, 0), b3, voffB); PG8_STAGE(PG8_SB(1, 1), b3 + hstepB, voffB); PG8_STAGE(PG8_SA(1, 0), a3, voffA);
            PG8_WAIT_V(8); PG8_WAIT_L(0); PG8_BAR; PG8_MMA(1, 0, At, B0); PG8_MMA(1, 1, At, B1); PG8_BAR; PG8_SCHED;
            } else {
            PG8_LDB(B0, 0, 0); PG8_SCHED; PG8_LDA(At, 0, 0); PG8_STAGE(PG8_SA(1, 1), a1 + hstepA, voffA);
            PG8_WAIT_L(8); PG8_BAR; PG8_WAIT_L(0); PG8_MMA(0, 0, At, B0); PG8_BAR; PG8_SCHED;
            PG8_LDB(B1, 0, 1); PG8_STAGE(PG8_SB(0, 0), b2, voffB);
            PG8_BAR; PG8_WAIT_L(0); PG8_MMA(0, 1, At, B1); PG8_BAR;
            PG8_LDA(At, 0, 1); PG8_STAGE(PG8_SA(0, 0), a2, voffA);
            PG8_BAR; PG8_WAIT_L(0); PG8_MMA(1, 0, At, B0); PG8_BAR; PG8_SCHED;
            PG8_STAGE(PG8_SB(0, 1), b2 + hstepB, voffB);
            PG8_WAIT_V(6); PG8_BAR; PG8_MMA(1, 1, At, B1); PG8_BAR;
            PG8_LDB(B0, 1, 0); PG8_SCHED; PG8_LDA(At, 1, 0); PG8_STAGE(PG8_SA(0, 1), a2 + hstepA, voffA);
            PG8_WAIT_L(8); PG8_BAR; PG8_WAIT_L(0); PG8_MMA(0, 0, At, B0); PG8_BAR; PG8_SCHED;
            PG8_LDB(B1, 1, 1); PG8_STAGE(PG8_SB(1, 0), b3, voffB);
            PG8_BAR; PG8_WAIT_L(0); PG8_MMA(0, 1, At, B1); PG8_BAR;
            PG8_LDA(At, 1, 1); PG8_STAGE(PG8_SA(1, 0), a3, voffA);
            PG8_BAR; PG8_WAIT_L(0); PG8_MMA(1, 0, At, B0); PG8_BAR; PG8_SCHED;
            PG8_STAGE(PG8_SB(1, 1), b3 + hstepB, voffB);
            PG8_WAIT_V(6); PG8_BAR; PG8_MMA(1, 1, At, B1); PG8_BAR;
            }
        }
        if constexpr (ALIGN_EPI) { if (wr == 0) PG8_BAR; }
        if constexpr (!Epi::AFTER_DRAIN) { int t2 = threadIdx.x; asm volatile("" : "+v"(t2)); const int w2 = __builtin_amdgcn_readfirstlane(t2 >> 6), l2 = t2 & 63;
            E(acc, cur, w2 >> 2, w2 & 3, l2 & 15, l2 >> 4); S.done(cur); }
        if (!has_next) break;
#pragma unroll
        for (int a = 0; a < 2; ++a)
#pragma unroll
            for (int b = 0; b < 2; ++b)
#pragma unroll
                for (int m = 0; m < 4; ++m)
#pragma unroll
                    for (int n = 0; n < 2; ++n) acc[a][b][m][n] = (f32x4){0.f, 0.f, 0.f, 0.f};
        cur = nxt; cA = nA; cB = nB; ++ui;
        if constexpr (ALIGN_EPI) { if (wr == 1) PG8_BAR; }
    }
    PG8_WAIT_V(0);
    if constexpr (!ALIGN_EPI) { if (wr == 0) PG8_BAR; }
    PG8_BAR;
    if constexpr (Epi::AFTER_DRAIN) { E.fused(acc, cur, wr, wc, fr, fq, lds, wid, lane); S.done(cur); }
#undef PG8_SA
#undef PG8_SB
#undef PG8_STAGE
#undef PG8_LDA
#undef PG8_LDB
#undef PG8_MMA
#undef PG8_WAIT_V
#undef PG8_WAIT_L
#undef PG8_BAR
#undef PG8_SCHED
}
}

constexpr int DM = 1024, SEQ = 4096, NB = 4, MROWS = NB * SEQ, SB = 32, MP = MROWS + 256;
constexpr int DEPTH = 4, INW = 4864, PW = 512, AW = 768, AO = 256, FF = 4096;
constexpr int NMOD = NB + SB, MODW = 6 * DM;
constexpr int NWAVES = 8, NTHREADS = 512;
constexpr float EPS = 1e-6f;
constexpr float C2 = 0.125f * 1.4426950408889634f;
enum { I_XP = 0, I_XS, I_CK0, I_CV0, I_CK1, I_CV1, I_CK2, I_CV2, I_STATE, I_CP, I_CS, I_N1G, I_N2G, I_WADA, I_BADA, I_WIN, I_QG, I_KG, I_WPG, I_PSC, I_WPB, I_WAB, I_WOUT, I_WUP, I_WDN, N_IN };
constexpr size_t O_YP = 0, O_YS = O_YP + (size_t)MROWS * DM;
constexpr size_t SZ_KP0 = (size_t)DEPTH * NB * 128 * 256, SZ_KP1 = (size_t)DEPTH * NB * 512 * 256, SZ_KP2 = (size_t)DEPTH * NB * 2048 * 256;
constexpr size_t O_KP0 = O_YS + (size_t)SB * DM, O_VP0 = O_KP0 + SZ_KP0, O_KP1 = O_VP0 + SZ_KP0, O_VP1 = O_KP1 + SZ_KP1, O_KP2 = O_VP1 + SZ_KP1, O_VP2 = O_KP2 + SZ_KP2;
constexpr size_t O_POOLP = O_VP2 + SZ_KP2;
constexpr size_t SZ_S = (size_t)DEPTH * SB * 256;
constexpr size_t O_KS0 = O_POOLP + (size_t)DEPTH * NB * 15 * PW, O_VS0 = O_KS0 + SZ_S, O_KS1 = O_VS0 + SZ_S, O_VS1 = O_KS1 + SZ_S, O_KS2 = O_VS1 + SZ_S, O_VS2 = O_KS2 + SZ_S;
constexpr size_t O_POOLS = O_VS2 + SZ_S, O_END = O_POOLS + (size_t)DEPTH * SB * 15 * PW;
static_assert(O_END == 40132608, "output size");

constexpr size_t MiB = 1u << 20;
constexpr size_t WS_CTL = 0, CTL_ZERO_BYTES = 1 * MiB;
constexpr size_t WS_MOD = 1 * MiB;
constexpr size_t WS_ROPE = 5 * MiB;
constexpr size_t WS_SMALL = 7 * MiB;
constexpr size_t WS_W = 8 * MiB, W_LAYER = 30 * MiB;
constexpr size_t WO_IN = 0, WO_CAT = WO_IN + (size_t)INW * DM * 2, WO_OUT = WO_CAT + (size_t)DM * 768 * 2, WO_UP = WO_OUT + (size_t)DM * DM * 2, WO_DN = WO_UP + (size_t)FF * DM * 2;
static_assert(WO_DN + (size_t)DM * FF * 2 <= W_LAYER, "weights per layer");
constexpr size_t WS_H = 128 * MiB, WS_U = 161 * MiB, WS_Q = 178 * MiB, WS_K = 203 * MiB, WS_V = 228 * MiB, WS_GP = 253 * MiB, WS_GA = 286 * MiB;
constexpr size_t WS_PA = 319 * MiB, WS_T = 344 * MiB, WS_MG = 377 * MiB, WS_UP = 410 * MiB, WS_END = 541 * MiB;
static_assert(WS_W + DEPTH * W_LAYER <= WS_H && (size_t)MP * DM * 2 <= 33 * MiB && (size_t)MP * PW * 2 <= 17 * MiB && (size_t)MP * AW * 2 <= 25 * MiB && (size_t)MP * FF * 2 <= 131 * MiB, "ws map");
constexpr int SM_US = 0, SM_QS = SM_US + SB * PW, SM_KS = SM_QS + SB * AW, SM_VS = SM_KS + SB * AW, SM_GP = SM_VS + SB * AW, SM_GA = SM_GP + SB * DM, SM_END = SM_GA + SB * DM;
static_assert((size_t)SM_END * 4 <= 1 * MiB, "small");
constexpr int CW_BAR = 4096;

constexpr int LDS_MISC = 156672, LDS_BYTES = 157696;

#define GAS __attribute__((address_space(1)))
#define LAS __attribute__((address_space(3)))
typedef unsigned short bf16;
typedef unsigned v4u __attribute__((ext_vector_type(4)));
typedef float f32x4 __attribute__((ext_vector_type(4)));
typedef short bf16x8 __attribute__((ext_vector_type(8)));
typedef GAS unsigned gu32;
typedef GAS unsigned long long gu64;
#define RLX_AGENT __ATOMIC_RELAXED, __HIP_MEMORY_SCOPE_AGENT
#define LDS_WAIT() asm volatile("s_waitcnt lgkmcnt(0)" ::: "memory")
#define VM_WAIT() asm volatile("s_waitcnt vmcnt(0)" ::: "memory")
__device__ __forceinline__ unsigned long long rt() { return __builtin_amdgcn_s_memrealtime(); }
__device__ __forceinline__ unsigned f2bf(float f) { unsigned u = __builtin_bit_cast(unsigned, f); return (u + 0x7fffu + ((u >> 16) & 1u)) >> 16; }
__device__ __forceinline__ unsigned pk2(float lo, float hi) { return f2bf(lo) | (f2bf(hi) << 16); }

#define XB_TMO      128
#define XB_XCNT(j)  (256  + 64 * (j))
#define XB_XSUB(j)  (1280 + 64 * (j))
#define XB_XGEN(j)  (2304 + 64 * (j))
#define XB_TOP      3328
#define XB_TOPGEN   3392
#define XCD_BAR_WORDS 3456
#define XB_SPIN_CAP (1u << 18)

__device__ __forceinline__ unsigned xb_ld(unsigned* p)              { return __hip_atomic_load(p, __ATOMIC_RELAXED, __HIP_MEMORY_SCOPE_AGENT); }
__device__ __forceinline__ unsigned xb_add(unsigned* p, unsigned v) { return __hip_atomic_fetch_add(p, v, __ATOMIC_RELAXED, __HIP_MEMORY_SCOPE_AGENT); }
__device__ __forceinline__ unsigned xb_xcc_id() { return (unsigned)__builtin_amdgcn_s_getreg((3 << 11) | 20) & 0xFu; }
#define XB_SPIN(cond, bar) do { unsigned _sp = 0; while (cond) { __builtin_amdgcn_s_sleep(1); \
    if ((++_sp & 255u) == 0u) { if (xb_ld(&(bar)[XB_TMO])) break; if (_sp > XB_SPIN_CAP) { atomicAdd(&(bar)[XB_TMO], 1u); break; } } } } while (0)

struct XcdBarrier {
    unsigned* bar; unsigned x;
    volatile LAS unsigned* st;
};

__device__ __forceinline__ XcdBarrier xcd_barrier_post(unsigned* bar, volatile LAS unsigned* st) {
    XcdBarrier b; b.bar = bar; b.x = xb_xcc_id(); b.st = st;
    if (threadIdx.x == 0) (void)xb_add(&bar[XB_XCNT(b.x)], 1u);
    return b;
}
__device__ __forceinline__ void xcd_barrier_complete(unsigned* bar, unsigned x, unsigned& nloc, unsigned& nx) {
    const unsigned G = gridDim.x * gridDim.y * gridDim.z;
    unsigned sum, cnt, mine, sp = 0u;
    for (;;) {
        sum = 0u; cnt = 0u; mine = 0u;
#pragma unroll
        for (unsigned j = 0; j < 16; ++j) { const unsigned c = xb_ld(&bar[XB_XCNT(j)]); sum += c; cnt += (c > 0u) ? 1u : 0u; mine = (j == x) ? c : mine; }
        if (sum == G) break;
        __builtin_amdgcn_s_sleep(1);
        if ((++sp & 255u) == 0u) { if (xb_ld(&bar[XB_TMO])) break; if (sp > XB_SPIN_CAP) { atomicAdd(&bar[XB_TMO], 1u); break; } }
    }
    nloc = mine > 0u ? mine : 1u; nx = cnt > 0u ? cnt : 1u;
}

__device__ __forceinline__ void xcd_barrier(const XcdBarrier& b) {
    asm volatile("s_waitcnt vmcnt(0)" ::: "memory");
    __syncthreads();
    if (threadIdx.x == 0) {
        unsigned* bar = b.bar; unsigned bx = b.x; asm volatile("" : "+s"(bar), "+s"(bx));
        __builtin_amdgcn_s_waitcnt(0);
        unsigned nloc = b.st[0], nx = b.st[1];
        if (nloc == 0u) { xcd_barrier_complete(bar, bx, nloc, nx); b.st[0] = nloc; b.st[1] = nx; }
        const unsigned old = xb_add(&bar[XB_XSUB(bx)], 1u);
        const unsigned gen = old / nloc;
        if (old + 1u == (gen + 1u) * nloc) {
            __builtin_amdgcn_fence(__ATOMIC_RELEASE, "agent");
            asm volatile("s_waitcnt vmcnt(0)" ::: "memory");
            const unsigned og = xb_add(&bar[XB_TOP], 1u);
            const unsigned tg = og / nx;
            if (og + 1u == (tg + 1u) * nx) xb_add(&bar[XB_TOPGEN], 1u);
            else XB_SPIN(xb_ld(&bar[XB_TOPGEN]) == tg, bar);
            __builtin_amdgcn_fence(__ATOMIC_ACQUIRE, "agent");
            xb_add(&bar[XB_XGEN(bx)], 1u);
            asm volatile("s_waitcnt vmcnt(0)" ::: "memory");
        } else {
            XB_SPIN(xb_ld(&bar[XB_XGEN(bx)]) == gen, bar);
            __builtin_amdgcn_fence(__ATOMIC_ACQUIRE, "agent");
            asm volatile("s_waitcnt vmcnt(0)" ::: "memory");
        }
    }
    __syncthreads();
}

typedef float f32x2 __attribute__((ext_vector_type(2)));
typedef unsigned u32x2 __attribute__((ext_vector_type(2)));
typedef short s16x4 __attribute__((ext_vector_type(4)));
template <int M> __device__ __forceinline__ float shx(float v) { return __uint_as_float((unsigned)__builtin_amdgcn_ds_swizzle((int)__float_as_uint(v), (M << 10) | 0x1f)); }
__device__ __forceinline__ float sum32(float v) { const auto r = __builtin_amdgcn_permlane32_swap(__float_as_uint(v), __float_as_uint(v), false, false); return __uint_as_float(r[0]) + __uint_as_float(r[1]); }
__device__ __forceinline__ float max32(float v) { const auto r = __builtin_amdgcn_permlane32_swap(__float_as_uint(v), __float_as_uint(v), false, false); return fmaxf(__uint_as_float(r[0]), __uint_as_float(r[1])); }
__device__ __forceinline__ float wave_sum(float v) { v += shx<1>(v); v += shx<2>(v); v += shx<4>(v); v += shx<8>(v); v += shx<16>(v); return sum32(v); }
typedef __bf16 bf16x2_t __attribute__((ext_vector_type(2)));
__device__ __forceinline__ unsigned cvtpk(float lo, float hi) { const f32x2 v = {lo, hi}; const bf16x2_t b = __builtin_convertvector(v, bf16x2_t); return __builtin_bit_cast(unsigned, b); }
__device__ __forceinline__ float bf_lo(unsigned w) { return __uint_as_float(w << 16); }
__device__ __forceinline__ float bf_hi(unsigned w) { return __uint_as_float(w & 0xffff0000u); }
__device__ __forceinline__ float sigmoidf_(float x) { return __builtin_amdgcn_rcpf(1.0f + __builtin_amdgcn_exp2f(-1.4426950408889634f * x)); }

struct Args { const float* in[N_IN]; float* out; unsigned char* ws; };

__device__ __forceinline__ void transpose_item(const float* W, int N, bf16* WT, int ldt, int k0, int srcn0, int dstrow0, LAS float* scr, int lane) {
#pragma unroll 8
    for (int i = 0; i < 32; ++i) { const int kk = 2 * i + (lane >> 5); scr[kk * 33 + (lane & 31)] = W[(size_t)(k0 + kk) * N + srcn0 + (lane & 31)]; }
    LDS_WAIT(); asm volatile("" ::: "memory");
    const int c = lane & 7;
#pragma unroll
    for (int j = 0; j < 4; ++j) { const int n = (lane >> 3) + 8 * j; const LAS float* s = scr + (8 * c) * 33 + n;
        v4u o; o.x = pk2(s[0 * 33], s[1 * 33]); o.y = pk2(s[2 * 33], s[3 * 33]); o.z = pk2(s[4 * 33], s[5 * 33]); o.w = pk2(s[6 * 33], s[7 * 33]);
        *(v4u*)(WT + (size_t)(dstrow0 + n) * ldt + k0 + 8 * c) = o; }
    LDS_WAIT(); asm volatile("" ::: "memory");
}
__device__ __forceinline__ int win_logical_col(int n) {
    const int tile = n >> 8;
    if (tile < 2 || tile >= 8) return n;
    const int p = n & 255, bj = p >> 7, wc = (p >> 5) & 3, i = p & 31;
    return tile * 256 + 64 * wc + 32 * bj + i;
}

__device__ __forceinline__ void phase0(const Args& a, LAS unsigned char* lds, int tid, int lane, int wave, int c, int G) {
    float* mod = (float*)(a.ws + WS_MOD);
    LAS float* silu = (LAS float*)lds;
    LAS float* red = (LAS float*)(lds + 147456);
    for (int idx = tid; idx < NMOD * DM; idx += NTHREADS) { const int r = idx >> 10, k = idx & 1023;
        const float cv = r < NB ? a.in[I_CP][r * DM + k] : a.in[I_CS][(r - NB) * DM + k];
        silu[idx] = cv / (1.0f + __expf(-cv)); }
    __syncthreads();
    for (int it = c; it < DEPTH * 192; it += G) {
        const int l = it / 192, n0 = 32 * (it % 192), kq = lane >> 4, np = lane & 15;
        const float* wl = a.in[I_WADA] + (size_t)l * DM * MODW + n0 + 2 * np;
        f32x2 acc[NMOD];
#pragma unroll
        for (int r = 0; r < NMOD; ++r) acc[r] = (f32x2){0.f, 0.f};
        const int kbase = 128 * wave + 32 * kq;
#pragma unroll 2
        for (int kk = 0; kk < 32; kk += 4) { const int k = kbase + kk;
            const f32x2 w0 = *(const f32x2*)(wl + (size_t)(k + 0) * MODW), w1 = *(const f32x2*)(wl + (size_t)(k + 1) * MODW), w2 = *(const f32x2*)(wl + (size_t)(k + 2) * MODW), w3 = *(const f32x2*)(wl + (size_t)(k + 3) * MODW);
#pragma unroll
            for (int r = 0; r < NMOD; ++r) { const f32x4 s = *(const LAS f32x4*)(silu + r * DM + k); acc[r] += w0 * s.x + w1 * s.y + w2 * s.z + w3 * s.w; } }
#pragma unroll
        for (int r = 0; r < NMOD; ++r) { acc[r].x += shx<16>(acc[r].x); acc[r].y += shx<16>(acc[r].y); acc[r].x = sum32(acc[r].x); acc[r].y = sum32(acc[r].y); }
#pragma unroll
        for (int qd = 0; qd < 4; ++qd) {
            if (kq == 0) {
#pragma unroll
                for (int rr = 0; rr < 9; ++rr) *(LAS f32x2*)(red + (wave * 9 + rr) * 32 + 2 * np) = acc[9 * qd + rr]; }
            __syncthreads();
            if (tid < 288) { const int rr = tid >> 5, col = tid & 31; float s = a.in[I_BADA][l * MODW + n0 + col];
#pragma unroll
                for (int w = 0; w < 8; ++w) s += red[(w * 9 + rr) * 32 + col];
                mod[(size_t)(l * NMOD + 9 * qd + rr) * MODW + n0 + col] = s; }
            __syncthreads();
        }
    }
    __syncthreads();
    for (int it = c; it < 128; it += G) {
        const int l = it >> 5, g = (it >> 3) & 3, kb = (it >> 2) & 1, nq = it & 3;
        LAS float* al = (LAS float*)lds;
        const float* src = a.in[I_WPG] + ((size_t)(l * 4 + g) * 128 + 64 * kb) * 128;
        for (int idx = tid; idx < 64 * 128; idx += NTHREADS) al[idx] = src[idx];
        __syncthreads();
        const int n = 32 * (nq * 8 + wave) + (lane & 31), h = lane >> 5;
        const float* wpb = a.in[I_WPB] + ((size_t)l * PW + 128 * g) * DM + n;
        const float* psc = a.in[I_PSC] + l * PW + 128 * g;
        float acc[32];
#pragma unroll
        for (int i = 0; i < 32; ++i) acc[i] = 0.f;
        for (int e4 = 0; e4 < 128; e4 += 4) {
            const float b0 = wpb[(size_t)(e4 + 0) * DM] * psc[e4 + 0], b1 = wpb[(size_t)(e4 + 1) * DM] * psc[e4 + 1], b2 = wpb[(size_t)(e4 + 2) * DM] * psc[e4 + 2], b3 = wpb[(size_t)(e4 + 3) * DM] * psc[e4 + 3];
#pragma unroll
            for (int i = 0; i < 32; ++i) { const f32x4 av = *(const LAS f32x4*)(al + (32 * h + i) * 128 + e4); acc[i] += av.x * b0 + av.y * b1 + av.z * b2 + av.w * b3; }
        }
        bf16* dst = (bf16*)(a.ws + WS_W + (size_t)l * W_LAYER + WO_CAT) + (size_t)n * 768 + 128 * g + 64 * kb + 32 * h;
#pragma unroll
        for (int i = 0; i < 32; i += 8) { v4u o; o.x = cvtpk(acc[i], acc[i + 1]); o.y = cvtpk(acc[i + 2], acc[i + 3]); o.z = cvtpk(acc[i + 4], acc[i + 5]); o.w = cvtpk(acc[i + 6], acc[i + 7]); *(v4u*)(dst + i) = o; }
        __syncthreads();
    }
    const int gw = c * NWAVES + wave, NGW = G * NWAVES;
    LAS float* scr = (LAS float*)(lds + wave * 16384);
    constexpr int IT_IN = (DM / 64) * (INW / 32), IT_AB = (AO / 64) * (DM / 32), IT_OUT = (DM / 64) * (DM / 32), IT_UP = (DM / 64) * (FF / 32), IT_DN = (FF / 64) * (DM / 32);
    constexpr int IT_LAYER = IT_IN + IT_AB + IT_OUT + IT_UP + IT_DN;
    for (int it = gw; it < DEPTH * IT_LAYER; it += NGW) {
        const int l = it / IT_LAYER; int r = it % IT_LAYER;
        unsigned char* wb = a.ws + WS_W + (size_t)l * W_LAYER;
        if (r < IT_IN) { const int nblk = INW / 32, kb = r / nblk, nb = r % nblk; transpose_item(a.in[I_WIN] + (size_t)l * DM * INW, INW, (bf16*)(wb + WO_IN), DM, 64 * kb, win_logical_col(32 * nb), 32 * nb, scr, lane); continue; } r -= IT_IN;
        if (r < IT_AB) { const int nblk = DM / 32, kb = r / nblk, nb = r % nblk; transpose_item(a.in[I_WAB] + (size_t)l * AO * DM, DM, (bf16*)(wb + WO_CAT) + 512, 768, 64 * kb, 32 * nb, 32 * nb, scr, lane); continue; } r -= IT_AB;
        if (r < IT_OUT) { const int nblk = DM / 32, kb = r / nblk, nb = r % nblk; transpose_item(a.in[I_WOUT] + (size_t)l * DM * DM, DM, (bf16*)(wb + WO_OUT), DM, 64 * kb, 32 * nb, 32 * nb, scr, lane); continue; } r -= IT_OUT;
        if (r < IT_UP) { const int nblk = FF / 32, kb = r / nblk, nb = r % nblk; transpose_item(a.in[I_WUP] + (size_t)l * DM * FF, FF, (bf16*)(wb + WO_UP), DM, 64 * kb, 32 * nb, 32 * nb, scr, lane); continue; } r -= IT_UP;
        { const int nblk = DM / 32, kb = r / nblk, nb = r % nblk; transpose_item(a.in[I_WDN] + (size_t)l * FF * DM, DM, (bf16*)(wb + WO_DN), FF, 64 * kb, 32 * nb, 32 * nb, scr, lane); }
    }
    {
        float* rope = (float*)(a.ws + WS_ROPE);
        for (int idx = c * NTHREADS + tid; idx < 4097 * 32; idx += G * NTHREADS) { const int p = idx >> 5, i = idx & 31;
            const float pos = p < 4096 ? (float)p : 8192.0f;
            const float inv = exp2f(-(float)i * (13.287712379549449f / 32.0f));
            const float ang = pos * inv;
            const double x = (double)ang * 0.15915494309189535; const double fr = x - __builtin_rint(x);
            const float f = (float)fr;
            rope[2 * idx] = __builtin_amdgcn_cosf(f); rope[2 * idx + 1] = __builtin_amdgcn_sinf(f); }
    }
    {
        float* dst = a.out + O_POOLS; const float* st = a.in[I_STATE];
        for (int idx = c * NTHREADS + tid; idx < DEPTH * SB * 14 * PW; idx += G * NTHREADS) { const int lb = idx / (14 * PW), rem = idx % (14 * PW);
            dst[(size_t)lb * 15 * PW + rem] = st[(size_t)lb * 15 * PW + PW + rem]; }
    }
}

__device__ __forceinline__ void norm_phase(const Args& a, int l, int which, int lane, int gw, int NGW) {
    const float* mod = (const float*)(a.ws + WS_MOD); bf16* H = (bf16*)(a.ws + WS_H);
    const float* gain = a.in[which ? I_N2G : I_N1G] + l * DM;
    const bool first = (l == 0 && which == 0);
    for (int row = gw; row < MROWS + SB; row += NGW) {
        const float* src; int mr;
        if (row < MROWS) { src = (first ? a.in[I_XP] : a.out + O_YP) + (size_t)row * DM; mr = row >> 12; }
        else { src = (first ? a.in[I_XS] : a.out + O_YS) + (size_t)(row - MROWS) * DM; mr = NB + row - MROWS; }
        const float* mp = mod + (size_t)(l * NMOD + mr) * MODW + (which ? 3 * DM : 0);
        f32x4 v[4]; float ss = 0.f;
#pragma unroll
        for (int j = 0; j < 4; ++j) { v[j] = *(const f32x4*)(src + 256 * j + 4 * lane); ss += (v[j].x * v[j].x + v[j].y * v[j].y) + (v[j].z * v[j].z + v[j].w * v[j].w); }
        const float rstd = 1.0f / sqrtf(wave_sum(ss) * (1.0f / DM) + EPS);
#pragma unroll
        for (int j = 0; j < 4; ++j) { const int col = 256 * j + 4 * lane;
            const f32x4 gn = *(const f32x4*)(gain + col), sh = *(const f32x4*)(mp + col), sc = *(const f32x4*)(mp + DM + col);
            const f32x4 o = (v[j] * rstd * gn) * (sc + 1.0f) + sh;
            u32x2 w; w.x = cvtpk(o.x, o.y); w.y = cvtpk(o.z, o.w);
            *(u32x2*)(H + (size_t)row * DM + col) = w; }
    }
}

struct EpiIn {
    static constexpr bool PERM = true, AFTER_DRAIN = false;
    bf16 *U, *Q, *K, *V, *GP, *GA; const float *qg, *kg, *rope; float* out; int l;
    __device__ __forceinline__ void operator()(const pg8::f32x4 (&acc)[2][2][4][2], const pg8::Unit& u, int wr, int wc, int fr, int fq) const {
        const int pn = u.pn, row0 = u.pm * 256 + wr * 64 + fr;
        if (pn < 2) {
#pragma unroll
            for (int ai = 0; ai < 2; ++ai)
#pragma unroll
                for (int m = 0; m < 4; ++m) { const int row = row0 + ai * 128 + m * 16, t = row & (SEQ - 1), b = row >> 12;
#pragma unroll
                    for (int bj = 0; bj < 2; ++bj) { const int col = pn * 256 + bj * 128 + wc * 32 + 8 * fq; const pg8::f32x4 v0 = acc[ai][bj][m][0], v1 = acc[ai][bj][m][1];
                        v4u w; w.x = cvtpk(v0[0], v0[1]); w.y = cvtpk(v0[2], v0[3]); w.z = cvtpk(v1[0], v1[1]); w.w = cvtpk(v1[2], v1[3]);
                        *(v4u*)(U + (size_t)row * PW + col) = w;
                        if (t >= SEQ - 15) { float* o = out + O_POOLP + ((size_t)(l * NB + b) * 15 + (t - (SEQ - 15))) * PW + col; *(pg8::f32x4*)o = v0; *(pg8::f32x4*)(o + 4) = v1; } } }
        } else if (pn < 8) {
            const bool isk = pn >= 5; const int g = pn - (isk ? 5 : 2), head = 4 * g + wc, W = 128 << (2 * g);
            const float* gn = isk ? kg : qg;
            pg8::f32x4 gv[2][2];
#pragma unroll
            for (int bj = 0; bj < 2; ++bj)
#pragma unroll
                for (int n = 0; n < 2; ++n) gv[bj][n] = *(const pg8::f32x4*)(gn + 32 * bj + 8 * fq + 4 * n);
            bf16* dstb = (isk ? K : Q) + head * 64 + 8 * fq;
            float* ko = out + (g == 0 ? O_KP0 : g == 1 ? O_KP1 : O_KP2);
#pragma unroll
            for (int ai = 0; ai < 2; ++ai)
#pragma unroll
                for (int m = 0; m < 4; ++m) { const int row = row0 + ai * 128 + m * 16, t = row & (SEQ - 1), b = row >> 12;
                    float ss = 0.f;
#pragma unroll
                    for (int bj = 0; bj < 2; ++bj)
#pragma unroll
                        for (int n = 0; n < 2; ++n) { const pg8::f32x4 v = acc[ai][bj][m][n]; ss += (v[0] * v[0] + v[1] * v[1]) + (v[2] * v[2] + v[3] * v[3]); }
                    ss += shx<16>(ss); ss = sum32(ss);
                    const float rstd = 1.0f / sqrtf(ss * (1.0f / 64.0f) + EPS);
                    pg8::f32x4 o1[2], o2[2];
#pragma unroll
                    for (int n = 0; n < 2; ++n) { const pg8::f32x4 y1 = acc[ai][0][m][n] * rstd * gv[0][n], y2 = acc[ai][1][m][n] * rstd * gv[1][n];
                        const float* rp = rope + ((size_t)t * 32 + 8 * fq + 4 * n) * 2; const pg8::f32x4 ra = *(const pg8::f32x4*)rp, rb = *(const pg8::f32x4*)(rp + 4);
                        const pg8::f32x4 cs = {ra[0], ra[2], rb[0], rb[2]}, sn = {ra[1], ra[3], rb[1], rb[3]};
                        o1[n] = y1 * cs - y2 * sn; o2[n] = y2 * cs + y1 * sn; }
                    if (!isk) { o1[0] *= C2; o1[1] *= C2; o2[0] *= C2; o2[1] *= C2; }
                    v4u w1, w2; w1.x = cvtpk(o1[0][0], o1[0][1]); w1.y = cvtpk(o1[0][2], o1[0][3]); w1.z = cvtpk(o1[1][0], o1[1][1]); w1.w = cvtpk(o1[1][2], o1[1][3]);
                    w2.x = cvtpk(o2[0][0], o2[0][1]); w2.y = cvtpk(o2[0][2], o2[0][3]); w2.z = cvtpk(o2[1][0], o2[1][1]); w2.w = cvtpk(o2[1][2], o2[1][3]);
                    *(v4u*)(dstb + (size_t)row * AW) = w1; *(v4u*)(dstb + (size_t)row * AW + 32) = w2;
                    if (isk && t >= SEQ - W) { float* o = ko + ((size_t)(l * NB + b) * W + (t - (SEQ - W))) * 256 + wc * 64 + 8 * fq;
                        *(pg8::f32x4*)o = o1[0]; *(pg8::f32x4*)(o + 4) = o1[1]; *(pg8::f32x4*)(o + 32) = o2[0]; *(pg8::f32x4*)(o + 36) = o2[1]; } }
        } else if (pn < 11) {
            const int g = pn - 8, W = 128 << (2 * g);
            float* vo = out + (g == 0 ? O_VP0 : g == 1 ? O_VP1 : O_VP2);
#pragma unroll
            for (int ai = 0; ai < 2; ++ai)
#pragma unroll
                for (int m = 0; m < 4; ++m) { const int row = row0 + ai * 128 + m * 16, t = row & (SEQ - 1), b = row >> 12;
#pragma unroll
                    for (int bj = 0; bj < 2; ++bj) { const int cl = bj * 128 + wc * 32 + 8 * fq; const pg8::f32x4 v0 = acc[ai][bj][m][0], v1 = acc[ai][bj][m][1];
                        v4u w; w.x = cvtpk(v0[0], v0[1]); w.y = cvtpk(v0[2], v0[3]); w.z = cvtpk(v1[0], v1[1]); w.w = cvtpk(v1[2], v1[3]);
                        *(v4u*)(V + (size_t)row * AW + g * 256 + cl) = w;
                        if (t >= SEQ - W) { float* o = vo + ((size_t)(l * NB + b) * W + (t - (SEQ - W))) * 256 + cl; *(pg8::f32x4*)o = v0; *(pg8::f32x4*)(o + 4) = v1; } } }
        } else {
            bf16* dst = pn < 15 ? GP + (pn - 11) * 256 : GA + (pn - 15) * 256;
#pragma unroll
            for (int ai = 0; ai < 2; ++ai)
#pragma unroll
                for (int m = 0; m < 4; ++m) { const int row = row0 + ai * 128 + m * 16;
#pragma unroll
                    for (int bj = 0; bj < 2; ++bj) { const int cl = bj * 128 + wc * 32 + 8 * fq; const pg8::f32x4 v0 = acc[ai][bj][m][0], v1 = acc[ai][bj][m][1];
                        v4u w; w.x = cvtpk(sigmoidf_(v0[0]), sigmoidf_(v0[1])); w.y = cvtpk(sigmoidf_(v0[2]), sigmoidf_(v0[3])); w.z = cvtpk(sigmoidf_(v1[0]), sigmoidf_(v1[1])); w.w = cvtpk(sigmoidf_(v1[2]), sigmoidf_(v1[3]));
                        *(v4u*)(dst + (size_t)row * DM + cl) = w; } }
        }
    }
};
template <int MODE> struct EpiEw {
    static constexpr bool PERM = true, AFTER_DRAIN = false;
    const bf16* G; const bf16* Tin; bf16* O; int ldc;
    __device__ __forceinline__ void operator()(const pg8::f32x4 (&acc)[2][2][4][2], const pg8::Unit& u, int wr, int wc, int fr, int fq) const {
        const int row0 = u.pm * 256 + wr * 64 + fr, col0 = u.pn * 256 + wc * 32 + 8 * fq;
#pragma unroll
        for (int ai = 0; ai < 2; ++ai)
#pragma unroll
            for (int m = 0; m < 4; ++m) { const size_t ro = (size_t)(row0 + ai * 128 + m * 16) * ldc + col0;
#pragma unroll
                for (int bj = 0; bj < 2; ++bj) { const size_t off = ro + bj * 128; const pg8::f32x4 a0 = acc[ai][bj][m][0], a1 = acc[ai][bj][m][1];
                    float r[8] = {a0[0], a0[1], a0[2], a0[3], a1[0], a1[1], a1[2], a1[3]};
                    if (MODE == 0 || MODE == 1) { const v4u gw = *(const v4u*)(G + off); const unsigned gq[4] = {gw.x, gw.y, gw.z, gw.w};
#pragma unroll
                        for (int q = 0; q < 4; ++q) { r[2 * q] *= bf_lo(gq[q]); r[2 * q + 1] *= bf_hi(gq[q]); } }
                    if (MODE == 1) { const v4u tw = *(const v4u*)(Tin + off); const unsigned tq[4] = {tw.x, tw.y, tw.z, tw.w};
#pragma unroll
                        for (int q = 0; q < 4; ++q) { r[2 * q] += bf_lo(tq[q]); r[2 * q + 1] += bf_hi(tq[q]); } }
                    if (MODE == 2) {
#pragma unroll
                        for (int q = 0; q < 8; ++q) { const float x = fmaxf(r[q], 0.f); r[q] = x * x; } }
                    v4u w; w.x = cvtpk(r[0], r[1]); w.y = cvtpk(r[2], r[3]); w.z = cvtpk(r[4], r[5]); w.w = cvtpk(r[6], r[7]);
                    *(v4u*)(O + off) = w; }
                if (MODE != 2) asm volatile("" ::: "memory"); }
    }
};
struct EpiRes {
    static constexpr bool PERM = false, AFTER_DRAIN = false;
    const float* base; float* outp; const float* gate;
    __device__ __forceinline__ void operator()(const pg8::f32x4 (&acc)[2][2][4][2], const pg8::Unit& u, int wr, int wc, int fr, int fq) const {
        const int row0 = u.pm * 256 + wr * 64 + fr, col0 = u.pn * 256 + wc * 32 + 4 * fq, b = (u.pm * 256) >> 12;
        pg8::f32x4 gv[2][2];
#pragma unroll
        for (int bj = 0; bj < 2; ++bj)
#pragma unroll
            for (int n = 0; n < 2; ++n) gv[bj][n] = *(const pg8::f32x4*)(gate + (size_t)b * MODW + col0 + bj * 128 + n * 16);
#pragma unroll
        for (int ai = 0; ai < 2; ++ai)
#pragma unroll
            for (int m = 0; m < 4; ++m) { const size_t ro = (size_t)(row0 + ai * 128 + m * 16) * DM + col0;
#pragma unroll
                for (int bj = 0; bj < 2; ++bj)
#pragma unroll
                    for (int n = 0; n < 2; ++n) { const size_t off = ro + bj * 128 + n * 16; *(pg8::f32x4*)(outp + off) = *(const pg8::f32x4*)(base + off) + gv[bj][n] * acc[ai][bj][m][n]; } }
    }
};

template <int W> __device__ __forceinline__ void pool_item(const bf16* U, bf16* PA, int b, int t0, int gi, int lane) {
    const unsigned* up = (const unsigned*)(U + (size_t)b * SEQ * PW + 128 * gi) + lane;
    float x0[32 + W - 1], x1[32 + W - 1];
#pragma unroll
    for (int i = 0; i < 32 + W - 1; ++i) { const int t = t0 - (W - 1) + i; const unsigned w = t >= 0 ? up[(size_t)t * (PW / 2)] : 0u; x0[i] = bf_lo(w); x1[i] = bf_hi(w); }
    unsigned* pp = (unsigned*)(PA + ((size_t)b * SEQ + t0) * AW + 128 * gi) + lane;
#pragma unroll
    for (int o = 0; o < 32; ++o) { const int t = t0 + o; float s0 = 0.f, s1 = 0.f;
#pragma unroll
        for (int i = 0; i < W; ++i) { s0 += x0[o + i]; s1 += x1[o + i]; }
        const int cnt = (t + 1 < W) ? (t + 1) : W; const float rc = 1.0f / (float)cnt;
        pp[(size_t)o * (AW / 2)] = cvtpk(s0 * rc - x0[o + W - 1], s1 * rc - x1[o + W - 1]); }
}

#ifndef ATTN_TR
#define ATTN_TR 0
#endif
constexpr int AT_ORUN = 0, AT_OPITCH = 68, AT_M = 256 * AT_OPITCH * 4, AT_L = AT_M + 1024, AT_VST = 73728;
__device__ __forceinline__ void attn_unit(LAS unsigned char* lds, const bf16* Q, const bf16* K, const bf16* V, bf16* PA, int b, int j, int pb, int wave, int lane) {
    LAS float* Orun = (LAS float*)(lds + AT_ORUN); LAS float* mrun = (LAS float*)(lds + AT_M); LAS float* lrun = (LAS float*)(lds + AT_L);
    LAS unsigned char* vst = lds + AT_VST + wave * 4096;
    const int fr = lane & 15, fq = lane >> 4, T0 = pb * 256;
    const size_t rb = (size_t)b * SEQ;
    const float NEG_INF = -__builtin_inff();
#pragma unroll
    for (int g = 0; g < 3; ++g) {
        const int dsh = 2 * g, head = 4 * g + j;
        for (int it2 = 0; it2 < 2; ++it2) {
            const int item = wave * 2 + it2, r = item & ((1 << dsh) - 1), cblk = item >> dsh, i0 = (T0 >> dsh) + 16 * cblk;
            const int qpos = ((i0 + fr) << dsh) + r;
            const bf16* qp = Q + (rb + qpos) * AW + head * 64 + 8 * fq;
            const bf16x8 q0 = *(const bf16x8*)qp, q1 = *(const bf16x8*)(qp + 32);
            f32x4 S[9];
#pragma unroll
            for (int kb = 0; kb < 9; ++kb) { int ki = i0 - 128 + 16 * kb + fr; ki = ki < 0 ? 0 : ki;
                const bf16* kp = K + (rb + (size_t)((ki << dsh) + r)) * AW + head * 64 + 8 * fq;
                const bf16x8 k0 = *(const bf16x8*)kp, k1 = *(const bf16x8*)(kp + 32);
                f32x4 z = {0.f, 0.f, 0.f, 0.f};
                z = __builtin_amdgcn_mfma_f32_16x16x32_bf16(k0, q0, z, 0, 0, 0);
                S[kb] = __builtin_amdgcn_mfma_f32_16x16x32_bf16(k1, q1, z, 0, 0, 0); }
            float mx = NEG_INF;
#pragma unroll
            for (int kb = 0; kb < 9; ++kb) { const bool bv = (i0 - 128 + 16 * kb) >= 0;
#pragma unroll
                for (int e = 0; e < 4; ++e) { const int m = 4 * fq + e; const bool ok = bv && (kb == 0 ? (m >= fr) : (kb == 8 ? (m <= fr) : true));
                    S[kb][e] = ok ? S[kb][e] : NEG_INF; mx = fmaxf(mx, S[kb][e]); } }
            mx = fmaxf(mx, shx<16>(mx)); mx = max32(mx);
            float ls = 0.f;
#pragma unroll
            for (int kb = 0; kb < 9; ++kb)
#pragma unroll
                for (int e = 0; e < 4; ++e) { const float p = __builtin_amdgcn_exp2f(S[kb][e] - mx); S[kb][e] = p; ls += p; }
            ls += shx<16>(ls); ls = sum32(ls);
            f32x4 O[4];
#pragma unroll
            for (int c = 0; c < 4; ++c) O[c] = (f32x4){0.f, 0.f, 0.f, 0.f};
#pragma unroll
            for (int pp = 0; pp < 5; ++pp) {
                const int kb0 = 2 * pp, kb1 = (2 * pp + 1 > 8) ? 8 : 2 * pp + 1;
#pragma unroll
                for (int i = 0; i < 4; ++i) { const int kl = (lane >> 3) + 8 * i, kbx = kl < 16 ? kb0 : kb1; int ki = i0 - 128 + 16 * kbx + (kl & 15); ki = ki < 0 ? 0 : ki;
                    const v4u vv = *(const v4u*)(V + (rb + (size_t)((ki << dsh) + r)) * AW + head * 64 + (lane & 7) * 8);
                    *(LAS v4u*)(vst + kl * 128 + (lane & 7) * 16) = vv; }
                v4u pw; pw.x = cvtpk(S[kb0][0], S[kb0][1]); pw.y = cvtpk(S[kb0][2], S[kb0][3]);
                if (2 * pp + 1 <= 8) { pw.z = cvtpk(S[kb1][0], S[kb1][1]); pw.w = cvtpk(S[kb1][2], S[kb1][3]); } else { pw.z = 0u; pw.w = 0u; }
                const bf16x8 Pf = __builtin_bit_cast(bf16x8, pw);
#pragma unroll
                for (int c = 0; c < 4; ++c) {
                    bf16x8 Vf;
#if ATTN_TR
                    { const LAS unsigned char* ap = vst + (4 * fq + (fr >> 2)) * 128 + 32 * c + 8 * (fr & 3);
                      const s16x4 lo = __builtin_bit_cast(s16x4, __builtin_amdgcn_ds_read_tr16_b64_v4i16((LAS s16x4*)ap));
                      const s16x4 hi = __builtin_bit_cast(s16x4, __builtin_amdgcn_ds_read_tr16_b64_v4i16((LAS s16x4*)(ap + 16 * 128)));
                      Vf = (bf16x8){lo[0], lo[1], lo[2], lo[3], hi[0], hi[1], hi[2], hi[3]}; }
#else
#pragma unroll
                    for (int e = 0; e < 8; ++e) { const int kl = 16 * (e >> 2) + 4 * fq + (e & 3); Vf[e] = *(const LAS short*)(vst + kl * 128 + (16 * c + fr) * 2); }
#endif
                    O[c] = __builtin_amdgcn_mfma_f32_16x16x32_bf16(Vf, Pf, O[c], 0, 0, 0); }
            }
            const int ql = qpos - T0;
            LAS float* orow = Orun + ql * AT_OPITCH + 4 * fq;
            if (g == 0) {
#pragma unroll
                for (int c = 0; c < 4; ++c) *(LAS f32x4*)(orow + 16 * c) = O[c];
                if (fq == 0) { mrun[ql] = mx; lrun[ql] = ls; }
            } else {
                const float mo = mrun[ql], lo = lrun[ql], mn = fmaxf(mo, mx), fa = __builtin_amdgcn_exp2f(mo - mn), fb = __builtin_amdgcn_exp2f(mx - mn), ln = fa * lo + fb * ls;
                if (g == 1) {
#pragma unroll
                    for (int c = 0; c < 4; ++c) { const f32x4 oo = *(const LAS f32x4*)(orow + 16 * c); *(LAS f32x4*)(orow + 16 * c) = oo * fa + O[c] * fb; }
                    if (fq == 0) { mrun[ql] = mn; lrun[ql] = ln; }
                } else {
                    const float inv = 1.0f / ln;
                    bf16* op = PA + (rb + qpos) * AW + PW + j * 64 + 4 * fq;
#pragma unroll
                    for (int c = 0; c < 4; ++c) { const f32x4 oo = *(const LAS f32x4*)(orow + 16 * c); const f32x4 rr = (oo * fa + O[c] * fb) * inv;
                        u32x2 w; w.x = cvtpk(rr[0], rr[1]); w.y = cvtpk(rr[2], rr[3]); *(u32x2*)(op + 16 * c) = w; }
                }
            }
        }
        __syncthreads();
    }
}

__device__ __forceinline__ void sample_attn_item(const Args& a, int l, int b, int hh, int lane) {
    const float* sm = (const float*)(a.ws + WS_SMALL);
    const int dl = lane & 15, ks = lane >> 4;
    float mrun = -__builtin_inff(), lrun = 0.f; f32x4 orun = {0.f, 0.f, 0.f, 0.f};
#pragma unroll
    for (int g = 0; g < 3; ++g) {
        const int hist = 128 << (2 * g), dil = 1 << (2 * g), head = 4 * g + hh;
        const float* ck = a.in[I_CK0 + 2 * g] + ((size_t)(l * SB + b) * hist) * 256 + hh * 64 + 4 * dl;
        const float* cv = a.in[I_CV0 + 2 * g] + ((size_t)(l * SB + b) * hist) * 256 + hh * 64 + 4 * dl;
        const f32x4 q = *(const f32x4*)(sm + SM_QS + b * AW + head * 64 + 4 * dl);
        const float* knew = sm + SM_KS + b * AW + head * 64 + 4 * dl; const float* vnew = sm + SM_VS + b * AW + head * 64 + 4 * dl;
#pragma unroll 3
        for (int it = 0; it < 33; ++it) { const int jk = 4 * it + ks; const bool ok = jk <= 128; const int jc = ok ? jk : 128;
            const size_t ro = (size_t)(hist - dil * jc) * 256;
            const float* kptr = (jc == 0) ? knew : ck + ro; const float* vptr = (jc == 0) ? vnew : cv + ro;
            const f32x4 kv = *(const f32x4*)kptr, vv = *(const f32x4*)vptr;
            float d = (kv.x * q.x + kv.y * q.y) + (kv.z * q.z + kv.w * q.w);
            d += shx<1>(d); d += shx<2>(d); d += shx<4>(d); d += shx<8>(d);
            d = ok ? d : -__builtin_inff();
            const float mn = fmaxf(mrun, d), fa = __builtin_amdgcn_exp2f(mrun - mn), p = __builtin_amdgcn_exp2f(d - mn);
            lrun = lrun * fa + p; orun = orun * fa + vv * p; mrun = mn; }
    }
    float mall = fmaxf(mrun, shx<16>(mrun)); mall = max32(mall);
    const float sc = __builtin_amdgcn_exp2f(mrun - mall);
    lrun *= sc; orun *= sc;
    lrun += shx<16>(lrun); lrun = sum32(lrun);
#pragma unroll
    for (int e = 0; e < 4; ++e) { orun[e] += shx<16>(orun[e]); orun[e] = sum32(orun[e]); }
    if (ks == 0) { const float inv = 1.0f / lrun; bf16* op = (bf16*)(a.ws + WS_PA) + (size_t)(MROWS + b) * AW + PW + hh * 64 + 4 * dl;
        u32x2 w; w.x = cvtpk(orun[0] * inv, orun[1] * inv); w.y = cvtpk(orun[2] * inv, orun[3] * inv); *(u32x2*)op = w; }
}
__device__ __forceinline__ void sample_pool_item(const Args& a, int l, int b, int lane) {
    const float* us = (const float*)(a.ws + WS_SMALL) + SM_US + b * PW + 8 * lane;
    const float* st = a.in[I_STATE] + (size_t)(l * SB + b) * 15 * PW + 8 * lane;
    const int W = 2 << (lane >> 4);
    const f32x4 u0 = *(const f32x4*)us, u1 = *(const f32x4*)(us + 4); f32x4 s0 = u0, s1 = u1;
    for (int i = 1; i < W; ++i) { s0 += *(const f32x4*)(st + (size_t)(15 - i) * PW); s1 += *(const f32x4*)(st + (size_t)(15 - i) * PW + 4); }
    const float rc = 1.0f / (float)W; const f32x4 p0 = s0 * rc - u0, p1 = s1 * rc - u1;
    v4u w; w.x = cvtpk(p0[0], p0[1]); w.y = cvtpk(p0[2], p0[3]); w.z = cvtpk(p1[0], p1[1]); w.w = cvtpk(p1[2], p1[3]);
    *(v4u*)((bf16*)(a.ws + WS_PA) + (size_t)(MROWS + b) * AW + 8 * lane) = w;
}

__device__ __forceinline__ f32x4 thin_tile(LAS unsigned char* lds, const bf16* A, int lda, const bf16* Bt, int ldb, int K, int cb0, int cb1, int cb2, int cb3, int tid, int wave, int lane) {
    const int fr = lane & 15, fq = lane >> 4, kw = K >> 3;
    f32x4 acc[2][4];
#pragma unroll
    for (int mb = 0; mb < 2; ++mb)
#pragma unroll
        for (int nb = 0; nb < 4; ++nb) acc[mb][nb] = (f32x4){0.f, 0.f, 0.f, 0.f};
    const bf16* ap = A + (size_t)fr * lda + wave * kw + 8 * fq;
    const bf16* bp0 = Bt + (size_t)(cb0 + fr) * ldb + wave * kw + 8 * fq; const bf16* bp1 = Bt + (size_t)(cb1 + fr) * ldb + wave * kw + 8 * fq;
    const bf16* bp2 = Bt + (size_t)(cb2 + fr) * ldb + wave * kw + 8 * fq; const bf16* bp3 = Bt + (size_t)(cb3 + fr) * ldb + wave * kw + 8 * fq;
    for (int k = 0; k < kw; k += 32) {
        const bf16x8 a0 = *(const bf16x8*)(ap + k), a1 = *(const bf16x8*)(ap + (size_t)16 * lda + k);
        const bf16x8 b0 = *(const bf16x8*)(bp0 + k), b1 = *(const bf16x8*)(bp1 + k), b2 = *(const bf16x8*)(bp2 + k), b3 = *(const bf16x8*)(bp3 + k);
        acc[0][0] = __builtin_amdgcn_mfma_f32_16x16x32_bf16(b0, a0, acc[0][0], 0, 0, 0); acc[1][0] = __builtin_amdgcn_mfma_f32_16x16x32_bf16(b0, a1, acc[1][0], 0, 0, 0);
        acc[0][1] = __builtin_amdgcn_mfma_f32_16x16x32_bf16(b1, a0, acc[0][1], 0, 0, 0); acc[1][1] = __builtin_amdgcn_mfma_f32_16x16x32_bf16(b1, a1, acc[1][1], 0, 0, 0);
        acc[0][2] = __builtin_amdgcn_mfma_f32_16x16x32_bf16(b2, a0, acc[0][2], 0, 0, 0); acc[1][2] = __builtin_amdgcn_mfma_f32_16x16x32_bf16(b2, a1, acc[1][2], 0, 0, 0);
        acc[0][3] = __builtin_amdgcn_mfma_f32_16x16x32_bf16(b3, a0, acc[0][3], 0, 0, 0); acc[1][3] = __builtin_amdgcn_mfma_f32_16x16x32_bf16(b3, a1, acc[1][3], 0, 0, 0);
    }
    LAS float* red = (LAS float*)lds;
    __syncthreads();
#pragma unroll
    for (int mb = 0; mb < 2; ++mb)
#pragma unroll
        for (int nb = 0; nb < 4; ++nb) *(LAS f32x4*)(red + (wave * 32 + 16 * mb + fr) * 64 + 16 * nb + 4 * fq) = acc[mb][nb];
    __syncthreads();
    const int row = tid >> 4, c4 = 4 * (tid & 15);
    f32x4 s = {0.f, 0.f, 0.f, 0.f};
#pragma unroll
    for (int w = 0; w < 8; ++w) s += *(const LAS f32x4*)(red + (w * 32 + row) * 64 + c4);
    return s;
}

#define THIN_FOR(ui, n) for (int ui = G - 1 - c; ui < (n); ui += G)

__device__ __forceinline__ void thin_in(const Args& a, LAS unsigned char* lds, int l, int c, int G, int tid, int wave, int lane) {
    const bf16* H = (const bf16*)(a.ws + WS_H) + (size_t)MROWS * DM; const bf16* Wt = (const bf16*)(a.ws + WS_W + (size_t)l * W_LAYER + WO_IN);
    float* sm = (float*)(a.ws + WS_SMALL); const float* rope = (const float*)(a.ws + WS_ROPE) + (size_t)4096 * 64;
    THIN_FOR(ui, 76) {
        int cb[4];
        const bool isq = ui >= 8 && ui < 20, isk = ui >= 20 && ui < 32;
        if (isq || isk) { const int hq = ui - (isq ? 8 : 20), tile = (isq ? 2 : 5) + (hq >> 2), wc = hq & 3;
#pragma unroll
            for (int nb = 0; nb < 4; ++nb) cb[nb] = tile * 256 + 128 * (nb >> 1) + 32 * wc + 16 * (nb & 1);
        } else {
#pragma unroll
            for (int nb = 0; nb < 4; ++nb) cb[nb] = 64 * ui + 16 * nb; }
        const f32x4 v = thin_tile(lds, H, DM, Wt, DM, DM, cb[0], cb[1], cb[2], cb[3], tid, wave, lane);
        const int b = tid >> 4, c4 = 4 * (tid & 15);
        if (ui < 8) { const int col = 64 * ui + c4;
            *(f32x4*)(sm + SM_US + b * PW + col) = v; *(f32x4*)(a.out + O_POOLS + ((size_t)(l * SB + b) * 15 + 14) * PW + col) = v;
        } else if (ui < 32) { const int hq = ui - (isq ? 8 : 20), g = hq >> 2, hh = hq & 3;
            float ss = (v[0] * v[0] + v[1] * v[1]) + (v[2] * v[2] + v[3] * v[3]);
            ss += shx<1>(ss); ss += shx<2>(ss); ss += shx<4>(ss); ss += shx<8>(ss);
            const float rstd = 1.0f / sqrtf(ss * (1.0f / 64.0f) + EPS);
            const f32x4 gn = *(const f32x4*)(a.in[isq ? I_QG : I_KG] + l * 64 + c4);
            const f32x4 y = v * rstd * gn;
            f32x4 yp; yp[0] = shx<8>(y[0]); yp[1] = shx<8>(y[1]); yp[2] = shx<8>(y[2]); yp[3] = shx<8>(y[3]);
            const int i0 = c4 & 31; const float* rp = rope + 2 * i0; const f32x4 ra = *(const f32x4*)rp, rb = *(const f32x4*)(rp + 4);
            const f32x4 cs = {ra[0], ra[2], rb[0], rb[2]}, sn = {ra[1], ra[3], rb[1], rb[3]};
            f32x4 o = (c4 < 32) ? (y * cs - yp * sn) : (y * cs + yp * sn);
            if (isq) { o *= C2; *(f32x4*)(sm + SM_QS + b * AW + hq * 64 + c4) = o; }
            else { *(f32x4*)(sm + SM_KS + b * AW + hq * 64 + c4) = o;
                *(f32x4*)(a.out + (g == 0 ? O_KS0 : g == 1 ? O_KS1 : O_KS2) + (size_t)(l * SB + b) * 256 + hh * 64 + c4) = o; }
        } else if (ui < 44) { const int hq = ui - 32, g = hq >> 2, hh = hq & 3;
            *(f32x4*)(sm + SM_VS + b * AW + hq * 64 + c4) = v;
            *(f32x4*)(a.out + (g == 0 ? O_VS0 : g == 1 ? O_VS1 : O_VS2) + (size_t)(l * SB + b) * 256 + hh * 64 + c4) = v;
        } else { const int col = 64 * (ui - (ui < 60 ? 44 : 60)) + c4; const f32x4 sg = {sigmoidf_(v[0]), sigmoidf_(v[1]), sigmoidf_(v[2]), sigmoidf_(v[3])};
            *(f32x4*)(sm + (ui < 60 ? SM_GP : SM_GA) + b * DM + col) = sg; }
    }
}
__device__ __forceinline__ void thin_gate(const Args& a, LAS unsigned char* lds, int l, int c, int G, int tid, int wave, int lane) {
    const bf16* PAs = (const bf16*)(a.ws + WS_PA) + (size_t)MROWS * AW; const bf16* Wc = (const bf16*)(a.ws + WS_W + (size_t)l * W_LAYER + WO_CAT);
    const float* sm = (const float*)(a.ws + WS_SMALL); bf16* MG = (bf16*)(a.ws + WS_MG) + (size_t)MROWS * DM;
    THIN_FOR(ui, 16) { const int n0 = 64 * ui;
        const f32x4 v1 = thin_tile(lds, PAs, AW, Wc, 768, PW, n0, n0 + 16, n0 + 32, n0 + 48, tid, wave, lane);
        const f32x4 v2 = thin_tile(lds, PAs + PW, AW, Wc + PW, 768, AO, n0, n0 + 16, n0 + 32, n0 + 48, tid, wave, lane);
        const int b = tid >> 4, col = n0 + 4 * (tid & 15);
        const f32x4 gp = *(const f32x4*)(sm + SM_GP + b * DM + col), ga = *(const f32x4*)(sm + SM_GA + b * DM + col);
        const f32x4 o = gp * v1 + ga * v2; u32x2 w; w.x = cvtpk(o[0], o[1]); w.y = cvtpk(o[2], o[3]);
        *(u32x2*)(MG + (size_t)b * DM + col) = w; }
}
__device__ __forceinline__ void thin_res(const Args& a, LAS unsigned char* lds, int l, int which, int c, int G, int tid, int wave, int lane) {
    const bf16* A = which ? (const bf16*)(a.ws + WS_UP) + (size_t)MROWS * FF : (const bf16*)(a.ws + WS_MG) + (size_t)MROWS * DM;
    const int K = which ? FF : DM;
    const bf16* Wt = (const bf16*)(a.ws + WS_W + (size_t)l * W_LAYER + (which ? WO_DN : WO_OUT));
    const float* gate = (const float*)(a.ws + WS_MOD) + (size_t)(l * NMOD + NB) * MODW + (which ? 5 : 2) * DM;
    const float* base = (l == 0 && which == 0) ? a.in[I_XS] : a.out + O_YS;
    THIN_FOR(ui, 16) { const int n0 = 64 * ui;
        const f32x4 v = thin_tile(lds, A, K, Wt, K, K, n0, n0 + 16, n0 + 32, n0 + 48, tid, wave, lane);
        const int b = tid >> 4, col = n0 + 4 * (tid & 15);
        const f32x4 gt = *(const f32x4*)(gate + (size_t)b * MODW + col), xb = *(const f32x4*)(base + b * DM + col);
        *(f32x4*)(a.out + O_YS + b * DM + col) = xb + gt * v; }
}
__device__ __forceinline__ void thin_up(const Args& a, LAS unsigned char* lds, int l, int c, int G, int tid, int wave, int lane) {
    const bf16* H = (const bf16*)(a.ws + WS_H) + (size_t)MROWS * DM; const bf16* Wt = (const bf16*)(a.ws + WS_W + (size_t)l * W_LAYER + WO_UP);
    bf16* UPs = (bf16*)(a.ws + WS_UP) + (size_t)MROWS * FF;
    THIN_FOR(ui, 64) { const int n0 = 64 * ui;
        const f32x4 v = thin_tile(lds, H, DM, Wt, DM, DM, n0, n0 + 16, n0 + 32, n0 + 48, tid, wave, lane);
        const int b = tid >> 4, col = n0 + 4 * (tid & 15);
        const float r0 = fmaxf(v[0], 0.f), r1 = fmaxf(v[1], 0.f), r2 = fmaxf(v[2], 0.f), r3 = fmaxf(v[3], 0.f);
        u32x2 w; w.x = cvtpk(r0 * r0, r1 * r1); w.y = cvtpk(r2 * r2, r3 * r3);
        *(u32x2*)(UPs + (size_t)b * FF + col) = w; }
}

#ifndef PHMASK
#define PHMASK 0xffffffffu
#endif
#define PH(k) ((PHMASK >> (k)) & 1u)
#define FRESH(t, ln, wv, gwv) int t = threadIdx.x; asm volatile("" : "+v"(t)); const int ln = t & 63, wv = __builtin_amdgcn_readfirstlane(t >> 6), gwv = c * NWAVES + wv; (void)ln; (void)gwv;
#ifndef N_LAYERS_RUN
#define N_LAYERS_RUN DEPTH
#endif
__global__ void __launch_bounds__(NTHREADS, 2) fwd(Args a) {
    extern __shared__ __attribute__((aligned(16))) unsigned char lds_raw[];
    LAS unsigned char* lds = (LAS unsigned char*)lds_raw;
    const int tid = threadIdx.x, lane = tid & 63, wave = __builtin_amdgcn_readfirstlane(tid >> 6);
    const int c = blockIdx.x, G = gridDim.x, NGW = G * NWAVES; (void)lane; (void)wave;
    volatile LAS unsigned* misc = (volatile LAS unsigned*)(lds + LDS_MISC);
    if (tid < 64) misc[tid] = 0u;
    __syncthreads();
    unsigned* ctl = (unsigned*)(a.ws + WS_CTL);
    XcdBarrier bar = xcd_barrier_post(ctl + CW_BAR, misc + 8);

#if PH(0)
    { FRESH(t0, ln0, wv0, gw0) phase0(a, lds, t0, ln0, wv0, c, G); }
#endif
    xcd_barrier(bar);

    bf16* const Hb = (bf16*)(a.ws + WS_H); bf16* const Ub = (bf16*)(a.ws + WS_U); bf16* const Qb = (bf16*)(a.ws + WS_Q); bf16* const Kb = (bf16*)(a.ws + WS_K); bf16* const Vb = (bf16*)(a.ws + WS_V);
    bf16* const GPb = (bf16*)(a.ws + WS_GP); bf16* const GAb = (bf16*)(a.ws + WS_GA); bf16* const PAb = (bf16*)(a.ws + WS_PA); bf16* const Tb = (bf16*)(a.ws + WS_T); bf16* const MGb = (bf16*)(a.ws + WS_MG); bf16* const UPb = (bf16*)(a.ws + WS_UP);
    const float* const modp = (const float*)(a.ws + WS_MOD);

    for (int l = 0; l < N_LAYERS_RUN; ++l) {
        const unsigned char* wl = a.ws + WS_W + (size_t)l * W_LAYER;
#if PH(1)
        { FRESH(t1, ln1, wv1, gw1) norm_phase(a, l, 0, ln1, gw1, NGW); }
#endif
        xcd_barrier(bar);
        {
            pg8::Gemm g{Hb, (const bf16*)(wl + WO_IN), MROWS, INW, DM, DM, DM}; pg8::StaticOrder S; S.init(MROWS, INW, G, c);
            EpiIn E{Ub, Qb, Kb, Vb, GPb, GAb, a.in[I_QG] + l * 64, a.in[I_KG] + l * 64, (const float*)(a.ws + WS_ROPE), a.out, l};
#if PH(2)
            pg8::gemm_phase<EpiIn, pg8::StaticOrder, true, true>(lds, g, S, E);
#endif
#if PH(3)
            { FRESH(t3, ln3, wv3, gw3) thin_in(a, lds, l, c, G, t3, wv3, ln3); }
#endif
        }
        xcd_barrier(bar);
        {
#if PH(4)
            { FRESH(t4, ln4, wv4, gw4) for (int it = gw4; it < NB * 128 * 4; it += NGW) { const int gi = it & 3, run = it >> 2, b = run >> 7, t0 = (run & 127) * 32;
                if (gi == 0) pool_item<2>(Ub, PAb, b, t0, 0, ln4); else if (gi == 1) pool_item<4>(Ub, PAb, b, t0, 1, ln4); else if (gi == 2) pool_item<8>(Ub, PAb, b, t0, 2, ln4); else pool_item<16>(Ub, PAb, b, t0, 3, ln4); } }
#endif
#if PH(5)
            { FRESH(t5, ln5, wv5, gw5) for (int un = c; un < NB * 4 * 16; un += G) { const int pb = un & 15, j = (un >> 4) & 3, b = un >> 6;
                __syncthreads();
                attn_unit(lds, Qb, Kb, Vb, PAb, b, j, pb, wv5, ln5); } }
#endif
#if PH(6)
            { FRESH(t6, ln6, wv6, gw6) for (int it = gw6; it < SB * 4; it += NGW) sample_attn_item(a, l, it >> 2, it & 3, ln6); }
#endif
#if PH(7)
            { FRESH(t7, ln7, wv7, gw7) for (int it = NGW - 1 - gw7; it < SB; it += NGW) sample_pool_item(a, l, it, ln7); }
#endif
        }
        xcd_barrier(bar);
        {
            pg8::Gemm g1{PAb, (const bf16*)(wl + WO_CAT), MROWS, DM, PW, AW, 768}; pg8::StaticOrder S; S.init(MROWS, DM, G, c);
            EpiEw<0> E1{GPb, nullptr, Tb, DM};
#if PH(8)
            pg8::gemm_phase<EpiEw<0>, pg8::StaticOrder, true, true>(lds, g1, S, E1);
#endif
            pg8::Gemm g2{PAb + PW, (const bf16*)(wl + WO_CAT) + PW, MROWS, DM, AO, AW, 768};
            EpiEw<1> E2{GAb, Tb, MGb, DM};
#if PH(9)
            pg8::gemm_phase<EpiEw<1>, pg8::StaticOrder, true, true>(lds, g2, S, E2);
#endif
#if PH(10)
            { FRESH(t10, ln10, wv10, gw10) thin_gate(a, lds, l, c, G, t10, wv10, ln10); }
#endif
        }
        xcd_barrier(bar);
        {
            pg8::Gemm g{MGb, (const bf16*)(wl + WO_OUT), MROWS, DM, DM, DM, DM}; pg8::StaticOrder S; S.init(MROWS, DM, G, c);
            EpiRes E{l == 0 ? a.in[I_XP] : a.out + O_YP, a.out + O_YP, modp + (size_t)l * NMOD * MODW + 2 * DM};
#if PH(11)
            pg8::gemm_phase<EpiRes, pg8::StaticOrder, true, true>(lds, g, S, E);
#endif
#if PH(12)
            { FRESH(t12, ln12, wv12, gw12) thin_res(a, lds, l, 0, c, G, t12, wv12, ln12); }
#endif
        }
        xcd_barrier(bar);
#if PH(13)
        { FRESH(t13, ln13, wv13, gw13) norm_phase(a, l, 1, ln13, gw13, NGW); }
#endif
        xcd_barrier(bar);
        {
            pg8::Gemm g{Hb, (const bf16*)(wl + WO_UP), MROWS, FF, DM, DM, DM}; pg8::StaticOrder S; S.init(MROWS, FF, G, c);
            EpiEw<2> E{nullptr, nullptr, UPb, FF};
#if PH(14)
            pg8::gemm_phase<EpiEw<2>, pg8::StaticOrder, true, true>(lds, g, S, E);
#endif
#if PH(15)
            { FRESH(t15, ln15, wv15, gw15) thin_up(a, lds, l, c, G, t15, wv15, ln15); }
#endif
        }
        xcd_barrier(bar);
        {
            pg8::Gemm g{UPb, (const bf16*)(wl + WO_DN), MROWS, DM, FF, FF, FF}; pg8::StaticOrder S; S.init(MROWS, DM, G, c);
            EpiRes E{a.out + O_YP, a.out + O_YP, modp + (size_t)l * NMOD * MODW + 5 * DM};
#if PH(16)
            pg8::gemm_phase<EpiRes, pg8::StaticOrder, true, true>(lds, g, S, E);
#endif
#if PH(17)
            { FRESH(t17, ln17, wv17, gw17) thin_res(a, lds, l, 1, c, G, t17, wv17, ln17); }
#endif
        }
        xcd_barrier(bar);
    }
    if (__hip_atomic_load(ctl + CW_BAR + XB_TMO, __ATOMIC_RELAXED, __HIP_MEMORY_SCOPE_AGENT) != 0u) {
        const float qn = __builtin_nanf("");
        for (int i = c * NTHREADS + tid; i < SB * DM; i += G * NTHREADS) a.out[O_YS + i] = qn;
    }
}

extern "C" void kernel_launch(void* const* d_in, const int* in_sizes, int n_in, void* d_out, int out_size, void* d_ws, size_t ws_size, hipStream_t stream) {
    static int grid = 0;
    if (grid == 0) {
        if (n_in != N_IN || (size_t)out_size != O_END || ws_size < WS_END) { fprintf(stderr, "kernel_launch: unexpected shapes: n_in %d out %d ws %zu; nothing launched\n", n_in, out_size, ws_size); grid = -1; return; }
        int dev = 0, cus = 0, per_cu = 0;
        if (hipGetDevice(&dev) != hipSuccess || hipDeviceGetAttribute(&cus, hipDeviceAttributeMultiprocessorCount, dev) != hipSuccess) { fprintf(stderr, "kernel_launch: device query failed\n"); grid = -1; return; }
        if (hipFuncSetAttribute((const void*)fwd, hipFuncAttributeMaxDynamicSharedMemorySize, LDS_BYTES) != hipSuccess) { fprintf(stderr, "kernel_launch: hipFuncSetAttribute failed\n"); grid = -1; return; }
        if (hipOccupancyMaxActiveBlocksPerMultiprocessor(&per_cu, (const void*)fwd, NTHREADS, LDS_BYTES) != hipSuccess || per_cu < 1) fprintf(stderr, "kernel_launch: note: occupancy query reports %d workgroups per CU\n", per_cu);
        (void)hipGetLastError();
        grid = cus;
    }
    if (grid < 0) return;
    if (hipMemsetAsync((char*)d_ws + WS_CTL, 0, CTL_ZERO_BYTES, stream) != hipSuccess) { fprintf(stderr, "kernel_launch: memset failed\n"); return; }
    Args a{};
    for (int i = 0; i < N_IN; ++i) a.in[i] = (const float*)d_in[i];
    a.out = (float*)d_out; a.ws = (unsigned char*)d_ws;
    hipLaunchKernelGGL(fwd, dim3(grid), dim3(NTHREADS), LDS_BYTES, stream, a);
    const hipError_t le = hipPeekAtLastError();
    if (le != hipSuccess) fprintf(stderr, "kernel_launch: launch failed: %s\n", hipGetErrorName(le));
}
```

```cpp
#include <hip/hip_runtime.h>
#include <cstdio>
#include <cstdint>
namespace pg8 {
#define PG8_LAS __attribute__((address_space(3)))
typedef unsigned short bf16_t;
typedef short bf16x8 __attribute__((ext_vector_type(8)));
typedef float f32x4 __attribute__((ext_vector_type(4)));
typedef unsigned u32x4 __attribute__((ext_vector_type(4)));
constexpr int BM = 256, BK = 64, HALF = 128, HTB = HALF * BK * 2  , STAGE_BYTES = 8 * HTB, NXCD = 8, WGM = 8;

__host__ __device__ __forceinline__ int lds_byte(int r, int c) { const int st = (r >> 4) * 2 + (c >> 5), rr = r & 15, cc = c & 31, ob = rr * 64 + cc * 2; return st * 1024 + (ob ^ (((ob >> 9) & 1) << 5)); }
__host__ __device__ __forceinline__ void stage_rc(int b, int& R, int& C) { const int st = b / 1024, sb = b % 1024, swz = sb ^ (((sb >> 9) & 1) << 5); R = (st >> 1) * 16 + swz / 64; C = (st & 1) * 32 + (swz % 64) / 2; }
__host__ __device__ __forceinline__ int perm32(int rho) { const int n = rho >> 4, i = rho & 15; return 8 * (i >> 2) + 4 * n + (i & 3); }

struct Unit { int pm, pn; };
struct Gemm { const bf16_t* A; const bf16_t* Bt; int M, N, K, lda, ldb; };

struct StaticOrder {
    int nM, nN, nwg, G, c;
    __host__ __device__ void init(int M, int N, int G_, int c_) { nM = M / BM; nN = N / BM; nwg = nM * nN; G = G_; c = c_; }
    __host__ __device__ bool next(int i, Unit& u) const {
        const long L = (long)i * G + c; if (L >= nwg) return false;
        int wgid = (int)L; { const int q = nwg / NXCD, r = nwg % NXCD, xcd = wgid % NXCD, off = wgid / NXCD; wgid = (xcd < r ? xcd * (q + 1) : r * (q + 1) + (xcd - r) * q) + off; }
        const int nig = WGM * nN, gid = wgid / nig, fm = gid * WGM, gsz = (nM - fm) < WGM ? (nM - fm) : WGM;
        u.pm = fm + ((wgid % nig) % gsz); u.pn = (wgid % nig) / gsz; return true;
    }
    __device__ __forceinline__ void a_ready(const Unit&) const {}
    __device__ __forceinline__ void done(const Unit&) const {}
};

__device__ __forceinline__ unsigned cvt_pk_bf16(float lo, float hi) { unsigned r; asm volatile("v_cvt_pk_bf16_f32 %0, %1, %2" : "=v"(r) : "v"(lo), "v"(hi)); return r; }
typedef float f32x2 __attribute__((ext_vector_type(2)));
template <class Epi, class Sched, bool ALIGN_EPI = false, bool SP2 = false>
__device__ __forceinline__ void gemm_phase(PG8_LAS unsigned char* lds, const Gemm g, const Sched& S, const Epi& E) {
    int tid_ = threadIdx.x; asm volatile("" : "+v"(tid_));
    const int tid = tid_, wid = __builtin_amdgcn_readfirstlane(tid >> 6), lane = tid & 63, wr = wid >> 2, wc = wid & 3, fr = lane & 15, fq = lane >> 4;
    const int K = g.K, nt = K / BK;
    unsigned voffA[2], voffB[2];
#pragma unroll
    for (int i = 0; i < 2; ++i) { int R, C; stage_rc(tid * 16 + i * 8192, R, C); const int Rb = Epi::PERM ? ((R & ~31) + perm32(R & 31)) : R;
        voffA[i] = (unsigned)(R * g.lda + C) * 2u; voffB[i] = (unsigned)(Rb * g.ldb + C) * 2u; }
    const size_t kstep = (size_t)(BK * 2);
    const size_t hstepA = (size_t)HALF * g.lda * 2, hstepB = (size_t)HALF * g.ldb * 2;
    const size_t tstepA = 2 * hstepA, tstepB = 2 * hstepB;
    const unsigned ldsw = (unsigned)wid * 1024u;
    const int aoff = lds_byte(wr * 64 + fr, fq * 8), boff = lds_byte(wc * 32 + fr, fq * 8);
#define PG8_SA(b, h) (((b) * 2 + (h)) * HTB)
#define PG8_SB(b, h) ((4 + (b) * 2 + (h)) * HTB)
#define PG8_STAGE(bufoff, gbase, voff) do { _Pragma("unroll") for (int _i = 0; _i < 2; ++_i) \
        __builtin_amdgcn_global_load_lds((const unsigned*)((const char*)(gbase) + (voff)[_i]), (PG8_LAS unsigned*)(lds + (bufoff) + ldsw + _i * 8192), 16, 0, 0); } while (0)
#define PG8_LDA(dst, b, h) do { _Pragma("unroll") for (int m = 0; m < 4; ++m) _Pragma("unroll") for (int k = 0; k < 2; ++k) dst[m][k] = *(const PG8_LAS bf16x8*)(lds + PG8_SA(b, h) + aoff + m * 2048 + k * 1024); } while (0)
#define PG8_LDB(dst, b, h) do { _Pragma("unroll") for (int n = 0; n < 2; ++n) _Pragma("unroll") for (int k = 0; k < 2; ++k) dst[n][k] = *(const PG8_LAS bf16x8*)(lds + PG8_SB(b, h) + boff + n * 2048 + k * 1024); } while (0)
#define PG8_MMA(ai, bj, At, Bt) do { __builtin_amdgcn_s_setprio(1); _Pragma("unroll") for (int m = 0; m < 4; ++m) _Pragma("unroll") for (int n = 0; n < 2; ++n) _Pragma("unroll") for (int k = 0; k < 2; ++k) \
        acc[ai][bj][m][n] = __builtin_amdgcn_mfma_f32_16x16x32_bf16(Bt[n][k], At[m][k], acc[ai][bj][m][n], 0, 0, 0); __builtin_amdgcn_s_setprio(0); } while (0)
#define PG8_WAIT_V(n) asm volatile("s_waitcnt vmcnt(" #n ")" ::: "memory")
#define PG8_WAIT_L(n) asm volatile("s_waitcnt lgkmcnt(" #n ")" ::: "memory")
#define PG8_BAR __builtin_amdgcn_s_barrier()
#define PG8_SCHED __builtin_amdgcn_sched_barrier(0)
    Unit cur, nxt; int ui = 0;
    if (!S.next(0, cur)) return;
    f32x4 acc[2][2][4][2];
#pragma unroll
    for (int a = 0; a < 2; ++a)
#pragma unroll
        for (int b = 0; b < 2; ++b)
#pragma unroll
            for (int m = 0; m < 4; ++m)
#pragma unroll
                for (int n = 0; n < 2; ++n) acc[a][b][m][n] = (f32x4){0.f, 0.f, 0.f, 0.f};
    bf16x8 At[4][2], B0[2][2], B1[2][2];
    const char* cA = (const char*)g.A + (size_t)cur.pm * tstepA; const char* cB = (const char*)g.Bt + (size_t)cur.pn * tstepB;
    S.a_ready(cur);
    if constexpr (SP2) {
        PG8_STAGE(PG8_SB(0, 0), cB, voffB); PG8_STAGE(PG8_SB(0, 1), cB + hstepB, voffB); PG8_STAGE(PG8_SA(0, 0), cA, voffA); PG8_STAGE(PG8_SA(0, 1), cA + hstepA, voffA);
        if (wr == 1) PG8_BAR;
        PG8_WAIT_V(2); PG8_BAR;
        PG8_STAGE(PG8_SB(1, 0), cB + kstep, voffB); PG8_STAGE(PG8_SA(1, 0), cA + kstep, voffA); PG8_STAGE(PG8_SB(1, 1), cB + hstepB + kstep, voffB);
        PG8_WAIT_V(6); PG8_BAR;
    } else {
        PG8_STAGE(PG8_SB(0, 0), cB, voffB); PG8_STAGE(PG8_SA(0, 0), cA, voffA); PG8_STAGE(PG8_SB(0, 1), cB + hstepB, voffB); PG8_STAGE(PG8_SA(0, 1), cA + hstepA, voffA);
        if (wr == 1) PG8_BAR;
        PG8_WAIT_V(4); PG8_BAR;
        PG8_STAGE(PG8_SB(1, 0), cB + kstep, voffB); PG8_STAGE(PG8_SA(1, 0), cA + kstep, voffA); PG8_STAGE(PG8_SB(1, 1), cB + hstepB + kstep, voffB);
        PG8_WAIT_V(6); PG8_BAR;
    }
    for (;;) {
        const bool has_next = S.next(ui + 1, nxt);
        const char* nA = has_next ? (const char*)g.A + (size_t)nxt.pm * tstepA : cA; const char* nB = has_next ? (const char*)g.Bt + (size_t)nxt.pn * tstepB : cB;
        for (int t = 0; t < nt; t += 2) {
            const bool last = (t == nt - 2);
            const char* a1 = cA + (size_t)(t + 1) * kstep;
            const char* a2 = last ? nA : cA + (size_t)(t + 2) * kstep; const char* b2 = last ? nB : cB + (size_t)(t + 2) * kstep;
            const char* a3 = a2 + kstep; const char* b3 = b2 + kstep;
            if (last && has_next) S.a_ready(nxt);
            if constexpr (SP2) {
            PG8_LDB(B0, 0, 0); PG8_LDB(B1, 0, 1); PG8_SCHED; PG8_LDA(At, 0, 0); PG8_STAGE(PG8_SA(1, 1), a1 + hstepA, voffA);
            PG8_WAIT_V(8); PG8_WAIT_L(0); PG8_BAR; PG8_MMA(0, 0, At, B0); PG8_MMA(0, 1, At, B1); PG8_BAR; PG8_SCHED;
            PG8_LDA(At, 0, 1); PG8_STAGE(PG8_SB(0, 0), b2, voffB); PG8_STAGE(PG8_SB(0, 1), b2 + hstepB, voffB); PG8_STAGE(PG8_SA(0, 0), a2, voffA);
            PG8_WAIT_V(8); PG8_WAIT_L(0); PG8_BAR; PG8_MMA(1, 0, At, B0); PG8_MMA(1, 1, At, B1); PG8_BAR; PG8_SCHED;
            PG8_LDB(B0, 1, 0); PG8_LDB(B1, 1, 1); PG8_SCHED; PG8_LDA(At, 1, 0); PG8_STAGE(PG8_SA(0, 1), a2 + hstepA, voffA);
            PG8_WAIT_V(8); PG8_WAIT_L(0); PG8_BAR; PG8_MMA(0, 0, At, B0); PG8_MMA(0, 1, At, B1); PG8_BAR; PG8_SCHED;
            PG8_LDA(At, 1, 1); PG8_STAGE(PG8_SB(1, 0), b3, voffB); PG8_STAGE(PG8_SB(1, 1), b3 + hstepB, voffB); PG8_STAGE(PG8_SA(1, 0), a3, voffA);
            PG8_WAIT_V(8); PG8_WAIT_L(0); PG8_BAR; PG8_MMA(1, 0, At, B0); PG8_MMA(1, 1, At, B1); PG8_BAR; PG8_SCHED;
            } else {
            PG8_LDB(B0, 0, 0); PG8_SCHED; PG8_LDA(At, 0, 0); PG8_STAGE(PG8_SA(1, 1), a1 + hstepA, voffA);
            PG8_WAIT_L(8); PG8_BAR; PG8_WAIT_L(0); PG8_MMA(0, 0, At, B0); PG8_BAR; PG8_SCHED;
            PG8_LDB(B1, 0, 1); PG8_STAGE(PG8_SB(0, 0), b2, voffB);
            PG8_BAR; PG8_WAIT_L(0); PG8_MMA(0, 1, At, B1); PG8_BAR;
            PG8_LDA(At, 0, 1); PG8_STAGE(PG8_SA(0, 0), a2, voffA);
            PG8_BAR; PG8_WAIT_L(0); PG8_MMA(1, 0, At, B0); PG8_BAR; PG8_SCHED;
            PG8_STAGE(PG8_SB(0, 1), b2 + hstepB, voffB);
            PG8_WAIT_V(6); PG8_BAR; PG8_MMA(1, 1, At, B1); PG8_BAR;
            PG8_LDB(B0, 1, 0); PG8_SCHED; PG8_LDA(At, 1, 0); PG8_STAGE(PG8_SA(0, 1), a2 + hstepA, voffA);
            PG8_WAIT_L(8); PG8_BAR; PG8_WAIT_L(0); PG8_MMA(0, 0, At, B0); PG8_BAR; PG8_SCHED;
            PG8_LDB(B1, 1, 1); PG8_STAGE(PG8_SB(1, 0), b3, voffB);
            PG8_BAR; PG8_WAIT_L(0); PG8_MMA(0, 1, At, B1); PG8_BAR;
            PG8_LDA(At, 1, 1); PG8_STAGE(PG8_SA(1, 0), a3, voffA);
            PG8_BAR; PG8_WAIT_L(0); PG8_MMA(1, 0, At, B0); PG8_BAR; PG8_SCHED;
            PG8_STAGE(PG8_SB(1, 1), b3 + hstepB, voffB);
            PG8_WAIT_V(6); PG8_BAR; PG8_MMA(1, 1, At, B1); PG8_BAR;
            }
        }
        if constexpr (ALIGN_EPI) { if (wr == 0) PG8_BAR; }
        if constexpr (!Epi::AFTER_DRAIN) { int t2 = threadIdx.x; asm volatile("" : "+v"(t2)); const int w2 = __builtin_amdgcn_readfirstlane(t2 >> 6), l2 = t2 & 63;
            E(acc, cur, w2 >> 2, w2 & 3, l2 & 15, l2 >> 4); S.done(cur); }
        if (!has_next) break;
#pragma unroll
        for (int a = 0; a < 2; ++a)
#pragma unroll
            for (int b = 0; b < 2; ++b)
#pragma unroll
                for (int m = 0; m < 4; ++m)
#pragma unroll
                    for (int n = 0; n < 2; ++n) acc[a][b][m][n] = (f32x4){0.f, 0.f, 0.f, 0.f};
        cur = nxt; cA = nA; cB = nB; ++ui;
        if constexpr (ALIGN_EPI) { if (wr == 1) PG8_BAR; }
    }
    PG8_WAIT_V(0);
    if constexpr (!ALIGN_EPI) { if (wr == 0) PG8_BAR; }
    PG8_BAR;
    if constexpr (Epi::AFTER_DRAIN) { E.fused(acc, cur, wr, wc, fr, fq, lds, wid, lane); S.done(cur); }
#undef PG8_SA
#undef PG8_SB
#undef PG8_STAGE
#undef PG8_LDA
#undef PG8_LDB
#undef PG8_MMA
#undef PG8_WAIT_V
#undef PG8_WAIT_L
#undef PG8_BAR
#undef PG8_SCHED
}
}

constexpr int DM = 1024, SEQ = 4096, NB = 4, MROWS = NB * SEQ, SB = 32, MP = MROWS + 256;
constexpr int DEPTH = 4, INW = 4864, PW = 512, AW = 768, AO = 256, FF = 4096;
constexpr int NMOD = NB + SB, MODW = 6 * DM;
constexpr int NWAVES = 8, NTHREADS = 512;
constexpr float EPS = 1e-6f;
constexpr float C2 = 0.125f * 1.4426950408889634f;
enum { I_XP = 0, I_XS, I_CK0, I_CV0, I_CK1, I_CV1, I_CK2, I_CV2, I_STATE, I_CP, I_CS, I_N1G, I_N2G, I_WADA, I_BADA, I_WIN, I_QG, I_KG, I_WPG, I_PSC, I_WPB, I_WAB, I_WOUT, I_WUP, I_WDN, N_IN };
constexpr size_t O_YP = 0, O_YS = O_YP + (size_t)MROWS * DM;
constexpr size_t SZ_KP0 = (size_t)DEPTH * NB * 128 * 256, SZ_KP1 = (size_t)DEPTH * NB * 512 * 256, SZ_KP2 = (size_t)DEPTH * NB * 2048 * 256;
constexpr size_t O_KP0 = O_YS + (size_t)SB * DM, O_VP0 = O_KP0 + SZ_KP0, O_KP1 = O_VP0 + SZ_KP0, O_VP1 = O_KP1 + SZ_KP1, O_KP2 = O_VP1 + SZ_KP1, O_VP2 = O_KP2 + SZ_KP2;
constexpr size_t O_POOLP = O_VP2 + SZ_KP2;
constexpr size_t SZ_S = (size_t)DEPTH * SB * 256;
constexpr size_t O_KS0 = O_POOLP + (size_t)DEPTH * NB * 15 * PW, O_VS0 = O_KS0 + SZ_S, O_KS1 = O_VS0 + SZ_S, O_VS1 = O_KS1 + SZ_S, O_KS2 = O_VS1 + SZ_S, O_VS2 = O_KS2 + SZ_S;
constexpr size_t O_POOLS = O_VS2 + SZ_S, O_END = O_POOLS + (size_t)DEPTH * SB * 15 * PW;
static_assert(O_END == 40132608, "output size");

constexpr size_t MiB = 1u << 20;
constexpr size_t WS_CTL = 0, CTL_ZERO_BYTES = 1 * MiB;
constexpr size_t WS_MOD = 1 * MiB;
constexpr size_t WS_ROPE = 5 * MiB;
constexpr size_t WS_SMALL = 7 * MiB;
constexpr size_t WS_W = 8 * MiB, W_LAYER = 30 * MiB;
constexpr size_t WO_IN = 0, WO_CAT = WO_IN + (size_t)INW * DM * 2, WO_OUT = WO_CAT + (size_t)DM * 768 * 2, WO_UP = WO_OUT + (size_t)DM * DM * 2, WO_DN = WO_UP + (size_t)FF * DM * 2;
static_assert(WO_DN + (size_t)DM * FF * 2 <= W_LAYER, "weights per layer");
constexpr size_t WS_H = 128 * MiB, WS_U = 161 * MiB, WS_Q = 178 * MiB, WS_K = 203 * MiB, WS_V = 228 * MiB, WS_GP = 253 * MiB, WS_GA = 286 * MiB;
constexpr size_t WS_PA = 319 * MiB, WS_T = 344 * MiB, WS_MG = 377 * MiB, WS_UP = 410 * MiB, WS_END = 541 * MiB;
static_assert(WS_W + DEPTH * W_LAYER <= WS_H && (size_t)MP * DM * 2 <= 33 * MiB && (size_t)MP * PW * 2 <= 17 * MiB && (size_t)MP * AW * 2 <= 25 * MiB && (size_t)MP * FF * 2 <= 131 * MiB, "ws map");
constexpr int SM_US = 0, SM_QS = SM_US + SB * PW, SM_KS = SM_QS + SB * AW, SM_VS = SM_KS + SB * AW, SM_GP = SM_VS + SB * AW, SM_GA = SM_GP + SB * DM, SM_END = SM_GA + SB * DM;
static_assert((size_t)SM_END * 4 <= 1 * MiB, "small");
constexpr int CW_BAR = 4096;

constexpr int LDS_MISC = 156672, LDS_BYTES = 157696;

#define GAS __attribute__((address_space(1)))
#define LAS __attribute__((address_space(3)))
typedef unsigned short bf16;
typedef unsigned v4u __attribute__((ext_vector_type(4)));
typedef float f32x4 __attribute__((ext_vector_type(4)));
typedef short bf16x8 __attribute__((ext_vector_type(8)));
typedef GAS unsigned gu32;
typedef GAS unsigned long long gu64;
#define RLX_AGENT __ATOMIC_RELAXED, __HIP_MEMORY_SCOPE_AGENT
#define LDS_WAIT() asm volatile("s_waitcnt lgkmcnt(0)" ::: "memory")
#define VM_WAIT() asm volatile("s_waitcnt vmcnt(0)" ::: "memory")
__device__ __forceinline__ unsigned long long rt() { return __builtin_amdgcn_s_memrealtime(); }
__device__ __forceinline__ unsigned f2bf(float f) { unsigned u = __builtin_bit_cast(unsigned, f); return (u + 0x7fffu + ((u >> 16) & 1u)) >> 16; }
__device__ __forceinline__ unsigned pk2(float lo, float hi) { return f2bf(lo) | (f2bf(hi) << 16); }

#define XB_TMO      128
#define XB_XCNT(j)  (256  + 64 * (j))
#define XB_XSUB(j)  (1280 + 64 * (j))
#define XB_XGEN(j)  (2304 + 64 * (j))
#define XB_TOP      3328
#define XB_TOPGEN   3392
#define XCD_BAR_WORDS 3456
#define XB_SPIN_CAP (1u << 18)

__device__ __forceinline__ unsigned xb_ld(unsigned* p)              { return __hip_atomic_load(p, __ATOMIC_RELAXED, __HIP_MEMORY_SCOPE_AGENT); }
__device__ __forceinline__ unsigned xb_add(unsigned* p, unsigned v) { return __hip_atomic_fetch_add(p, v, __ATOMIC_RELAXED, __HIP_MEMORY_SCOPE_AGENT); }
__device__ __forceinline__ unsigned xb_xcc_id() { return (unsigned)__builtin_amdgcn_s_getreg((3 << 11) | 20) & 0xFu; }
#define XB_SPIN(cond, bar) do { unsigned _sp = 0; while (cond) { __builtin_amdgcn_s_sleep(1); \
    if ((++_sp & 255u) == 0u) { if (xb_ld(&(bar)[XB_TMO])) break; if (_sp > XB_SPIN_CAP) { atomicAdd(&(bar)[XB_TMO], 1u); break; } } } } while (0)

struct XcdBarrier {
    unsigned* bar; unsigned x;
    volatile LAS unsigned* st;
};

__device__ __forceinline__ XcdBarrier xcd_barrier_post(unsigned* bar, volatile LAS unsigned* st) {
    XcdBarrier b; b.bar = bar; b.x = xb_xcc_id(); b.st = st;
    if (threadIdx.x == 0) (void)xb_add(&bar[XB_XCNT(b.x)], 1u);
    return b;
}
__device__ __forceinline__ void xcd_barrier_complete(unsigned* bar, unsigned x, unsigned& nloc, unsigned& nx) {
    const unsigned G = gridDim.x * gridDim.y * gridDim.z;
    unsigned sum, cnt, mine, sp = 0u;
    for (;;) {
        sum = 0u; cnt = 0u; mine = 0u;
#pragma unroll
        for (unsigned j = 0; j < 16; ++j) { const unsigned c = xb_ld(&bar[XB_XCNT(j)]); sum += c; cnt += (c > 0u) ? 1u : 0u; mine = (j == x) ? c : mine; }
        if (sum == G) break;
        __builtin_amdgcn_s_sleep(1);
        if ((++sp & 255u) == 0u) { if (xb_ld(&bar[XB_TMO])) break; if (sp > XB_SPIN_CAP) { atomicAdd(&bar[XB_TMO], 1u); break; } }
    }
    nloc = mine > 0u ? mine : 1u; nx = cnt > 0u ? cnt : 1u;
}

__device__ __forceinline__ void xcd_barrier(const XcdBarrier& b) {
    asm volatile("s_waitcnt vmcnt(0)" ::: "memory");
    __syncthreads();
    if (threadIdx.x == 0) {
        unsigned* bar = b.bar; unsigned bx = b.x; asm volatile("" : "+s"(bar), "+s"(bx));
        __builtin_amdgcn_s_waitcnt(0);
        unsigned nloc = b.st[0], nx = b.st[1];
        if (nloc == 0u) { xcd_barrier_complete(bar, bx, nloc, nx); b.st[0] = nloc; b.st[1] = nx; }
        const unsigned old = xb_add(&bar[XB_XSUB(bx)], 1u);
        const unsigned gen = old / nloc;
        if (old + 1u == (gen + 1u) * nloc) {
            __builtin_amdgcn_fence(__ATOMIC_RELEASE, "agent");
            asm volatile("s_waitcnt vmcnt(0)" ::: "memory");
            const unsigned og = xb_add(&bar[XB_TOP], 1u);
            const unsigned tg = og / nx;
            if (og + 1u == (tg + 1u) * nx) xb_add(&bar[XB_TOPGEN], 1u);
            else XB_SPIN(xb_ld(&bar[XB_TOPGEN]) == tg, bar);
            __builtin_amdgcn_fence(__ATOMIC_ACQUIRE, "agent");
            xb_add(&bar[XB_XGEN(bx)], 1u);
            asm volatile("s_waitcnt vmcnt(0)" ::: "memory");
        } else {
            XB_SPIN(xb_ld(&bar[XB_XGEN(bx)]) == gen, bar);
            __builtin_amdgcn_fence(__ATOMIC_ACQUIRE, "agent");
            asm volatile("s_waitcnt vmcnt(0)" ::: "memory");
        }
    }
    __syncthreads();
}

typedef float f32x2 __attribute__((ext_vector_type(2)));
typedef unsigned u32x2 __attribute__((ext_vector_type(2)));
typedef short s16x4 __attribute__((ext_vector_type(4)));
template <int M> __device__ __forceinline__ float shx(float v) { return __uint_as_float((unsigned)__builtin_amdgcn_ds_swizzle((int)__float_as_uint(v), (M << 10) | 0x1f)); }
__device__ __forceinline__ float sum32(float v) { const auto r = __builtin_amdgcn_permlane32_swap(__float_as_uint(v), __float_as_uint(v), false, false); return __uint_as_float(r[0]) + __uint_as_float(r[1]); }
__device__ __forceinline__ float max32(float v) { const auto r = __builtin_amdgcn_permlane32_swap(__float_as_uint(v), __float_as_uint(v), false, false); return fmaxf(__uint_as_float(r[0]), __uint_as_float(r[1])); }
__device__ __forceinline__ float wave_sum(float v) { v += shx<1>(v); v += shx<2>(v); v += shx<4>(v); v += shx<8>(v); v += shx<16>(v); return sum32(v); }
typedef __bf16 bf16x2_t __attribute__((ext_vector_type(2)));
__device__ __forceinline__ unsigned cvtpk(float lo, float hi) { const f32x2 v = {lo, hi}; const bf16x2_t b = __builtin_convertvector(v, bf16x2_t); return __builtin_bit_cast(unsigned, b); }
__device__ __forceinline__ float bf_lo(unsigned w) { return __uint_as_float(w << 16); }
__device__ __forceinline__ float bf_hi(unsigned w) { return __uint_as_float(w & 0xffff0000u); }
__device__ __forceinline__ float sigmoidf_(float x) { return __builtin_amdgcn_rcpf(1.0f + __builtin_amdgcn_exp2f(-1.4426950408889634f * x)); }

struct Args { const float* in[N_IN]; float* out; unsigned char* ws; };

__device__ __forceinline__ void transpose_item(const float* W, int N, bf16* WT, int ldt, int k0, int srcn0, int dstrow0, LAS float* scr, int lane) {
    float tv[32];
#pragma unroll
    for (int i = 0; i < 32; ++i) { const int kk = 2 * i + (lane >> 5); tv[i] = W[(size_t)(k0 + kk) * N + srcn0 + (lane & 31)]; }
#pragma unroll
    for (int i = 0; i < 32; ++i) { const int kk = 2 * i + (lane >> 5); scr[kk * 33 + (lane & 31)] = tv[i]; }
    LDS_WAIT(); asm volatile("" ::: "memory");
    const int c = lane & 7;
#pragma unroll
    for (int j = 0; j < 4; ++j) { const int n = (lane >> 3) + 8 * j; const LAS float* s = scr + (8 * c) * 33 + n;
        v4u o; o.x = pk2(s[0 * 33], s[1 * 33]); o.y = pk2(s[2 * 33], s[3 * 33]); o.z = pk2(s[4 * 33], s[5 * 33]); o.w = pk2(s[6 * 33], s[7 * 33]);
        *(v4u*)(WT + (size_t)(dstrow0 + n) * ldt + k0 + 8 * c) = o; }
    LDS_WAIT(); asm volatile("" ::: "memory");
}
__device__ __forceinline__ int win_logical_col(int n) {
    const int tile = n >> 8;
    if (tile < 2 || tile >= 8) return n;
    const int p = n & 255, bj = p >> 7, wc = (p >> 5) & 3, i = p & 31;
    return tile * 256 + 64 * wc + 32 * bj + i;
}

__device__ __forceinline__ void phase0(const Args& a, LAS unsigned char* lds, int tid, int lane, int wave, int c, int G) {
    float* mod = (float*)(a.ws + WS_MOD);
    LAS float* silu = (LAS float*)lds;
    LAS float* red = (LAS float*)(lds + 147456);
    for (int idx = tid; idx < NMOD * DM; idx += NTHREADS) { const int r = idx >> 10, k = idx & 1023;
        const float cv = r < NB ? a.in[I_CP][r * DM + k] : a.in[I_CS][(r - NB) * DM + k];
        silu[idx] = cv / (1.0f + __expf(-cv)); }
    __syncthreads();
    for (int it = c; it < DEPTH * 192; it += G) {
        const int l = it / 192, n0 = 32 * (it % 192), kq = lane >> 4, np = lane & 15;
        const float* wl = a.in[I_WADA] + (size_t)l * DM * MODW + n0 + 2 * np;
        f32x2 acc[NMOD];
#pragma unroll
        for (int r = 0; r < NMOD; ++r) acc[r] = (f32x2){0.f, 0.f};
        const int kbase = 128 * wave + 32 * kq;
        for (int kh = 0; kh < 32; kh += 16) {
            f32x2 wv[16];
#pragma unroll
            for (int kk = 0; kk < 16; ++kk) wv[kk] = *(const f32x2*)(wl + (size_t)(kbase + kh + kk) * MODW);
#pragma unroll
            for (int kk = 0; kk < 16; kk += 4) { const int k = kbase + kh + kk;
#pragma unroll
                for (int r = 0; r < NMOD; ++r) { const f32x4 s = *(const LAS f32x4*)(silu + r * DM + k); acc[r] += wv[kk] * s.x + wv[kk + 1] * s.y + wv[kk + 2] * s.z + wv[kk + 3] * s.w; } } }
#pragma unroll
        for (int r = 0; r < NMOD; ++r) { acc[r].x += shx<16>(acc[r].x); acc[r].y += shx<16>(acc[r].y); acc[r].x = sum32(acc[r].x); acc[r].y = sum32(acc[r].y); }
#pragma unroll
        for (int qd = 0; qd < 4; ++qd) {
            if (kq == 0) {
#pragma unroll
                for (int rr = 0; rr < 9; ++rr) *(LAS f32x2*)(red + (wave * 9 + rr) * 32 + 2 * np) = acc[9 * qd + rr]; }
            __syncthreads();
            if (tid < 288) { const int rr = tid >> 5, col = tid & 31; float s = a.in[I_BADA][l * MODW + n0 + col];
#pragma unroll
                for (int w = 0; w < 8; ++w) s += red[(w * 9 + rr) * 32 + col];
                mod[(size_t)(l * NMOD + 9 * qd + rr) * MODW + n0 + col] = s; }
            __syncthreads();
        }
    }
    __syncthreads();
    for (int it = c; it < 128; it += G) {
        const int l = it >> 5, g = (it >> 3) & 3, kb = (it >> 2) & 1, nq = it & 3;
        LAS float* al = (LAS float*)lds;
        const float* src = a.in[I_WPG] + ((size_t)(l * 4 + g) * 128 + 64 * kb) * 128;
        for (int idx = tid; idx < 64 * 128; idx += NTHREADS) al[idx] = src[idx];
        __syncthreads();
        const int n = 32 * (nq * 8 + wave) + (lane & 31), h = lane >> 5;
        const float* wpb = a.in[I_WPB] + ((size_t)l * PW + 128 * g) * DM + n;
        const float* psc = a.in[I_PSC] + l * PW + 128 * g;
        float acc[32];
#pragma unroll
        for (int i = 0; i < 32; ++i) acc[i] = 0.f;
        for (int e8 = 0; e8 < 128; e8 += 8) {
            float bv[8];
#pragma unroll
            for (int q = 0; q < 8; ++q) bv[q] = wpb[(size_t)(e8 + q) * DM] * psc[e8 + q];
#pragma unroll
            for (int q = 0; q < 8; q += 4)
#pragma unroll
                for (int i = 0; i < 32; ++i) { const f32x4 av = *(const LAS f32x4*)(al + (32 * h + i) * 128 + e8 + q); acc[i] += av.x * bv[q] + av.y * bv[q + 1] + av.z * bv[q + 2] + av.w * bv[q + 3];
                    if ((i & 15) == 15) asm volatile("" ::: "memory"); }
        }
        bf16* dst = (bf16*)(a.ws + WS_W + (size_t)l * W_LAYER + WO_CAT) + (size_t)n * 768 + 128 * g + 64 * kb + 32 * h;
#pragma unroll
        for (int i = 0; i < 32; i += 8) { v4u o; o.x = cvtpk(acc[i], acc[i + 1]); o.y = cvtpk(acc[i + 2], acc[i + 3]); o.z = cvtpk(acc[i + 4], acc[i + 5]); o.w = cvtpk(acc[i + 6], acc[i + 7]); *(v4u*)(dst + i) = o; }
        __syncthreads();
    }
    const int gw = c * NWAVES + wave, NGW = G * NWAVES;
    LAS float* scr = (LAS float*)(lds + wave * 16384);
    constexpr int IT_IN = (DM / 64) * (INW / 32), IT_AB = (AO / 64) * (DM / 32), IT_OUT = (DM / 64) * (DM / 32), IT_UP = (DM / 64) * (FF / 32), IT_DN = (FF / 64) * (DM / 32);
    constexpr int IT_LAYER = IT_IN + IT_AB + IT_OUT + IT_UP + IT_DN;
    for (int it = gw; it < DEPTH * IT_LAYER; it += NGW) {
        const int l = it / IT_LAYER; int r = it % IT_LAYER;
        unsigned char* wb = a.ws + WS_W + (size_t)l * W_LAYER;
        if (r < IT_IN) { const int nblk = INW / 32, kb = r / nblk, nb = r % nblk; transpose_item(a.in[I_WIN] + (size_t)l * DM * INW, INW, (bf16*)(wb + WO_IN), DM, 64 * kb, win_logical_col(32 * nb), 32 * nb, scr, lane); continue; } r -= IT_IN;
        if (r < IT_AB) { const int nblk = DM / 32, kb = r / nblk, nb = r % nblk; transpose_item(a.in[I_WAB] + (size_t)l * AO * DM, DM, (bf16*)(wb + WO_CAT) + 512, 768, 64 * kb, 32 * nb, 32 * nb, scr, lane); continue; } r -= IT_AB;
        if (r < IT_OUT) { const int nblk = DM / 32, kb = r / nblk, nb = r % nblk; transpose_item(a.in[I_WOUT] + (size_t)l * DM * DM, DM, (bf16*)(wb + WO_OUT), DM, 64 * kb, 32 * nb, 32 * nb, scr, lane); continue; } r -= IT_OUT;
        if (r < IT_UP) { const int nblk = FF / 32, kb = r / nblk, nb = r % nblk; transpose_item(a.in[I_WUP] + (size_t)l * DM * FF, FF, (bf16*)(wb + WO_UP), DM, 64 * kb, 32 * nb, 32 * nb, scr, lane); continue; } r -= IT_UP;
        { const int nblk = DM / 32, kb = r / nblk, nb = r % nblk; transpose_item(a.in[I_WDN] + (size_t)l * FF * DM, DM, (bf16*)(wb + WO_DN), FF, 64 * kb, 32 * nb, 32 * nb, scr, lane); }
    }
    {
        float* rope = (float*)(a.ws + WS_ROPE);
        for (int idx = c * NTHREADS + tid; idx < 4097 * 32; idx += G * NTHREADS) { const int p = idx >> 5, i = idx & 31;
            const float pos = p < 4096 ? (float)p : 8192.0f;
            const float inv = exp2f(-(float)i * (13.287712379549449f / 32.0f));
            const float ang = pos * inv;
            const double x = (double)ang * 0.15915494309189535; const double fr = x - __builtin_rint(x);
            const float f = (float)fr;
            rope[2 * idx] = __builtin_amdgcn_cosf(f); rope[2 * idx + 1] = __builtin_amdgcn_sinf(f); }
    }
    {
        float* dst = a.out + O_POOLS; const float* st = a.in[I_STATE];
        for (int idx = c * NTHREADS + tid; idx < DEPTH * SB * 14 * PW; idx += G * NTHREADS) { const int lb = idx / (14 * PW), rem = idx % (14 * PW);
            dst[(size_t)lb * 15 * PW + rem] = st[(size_t)lb * 15 * PW + PW + rem]; }
    }
}

__device__ __forceinline__ void norm_phase(const Args& a, int l, int which, int lane, int gw, int NGW) {
    const float* mod = (const float*)(a.ws + WS_MOD); bf16* H = (bf16*)(a.ws + WS_H);
    const float* gain = a.in[which ? I_N2G : I_N1G] + l * DM;
    const bool first = (l == 0 && which == 0);
    for (int row = gw; row < MROWS + SB; row += NGW) {
        const float* src; int mr;
        if (row < MROWS) { src = (first ? a.in[I_XP] : a.out + O_YP) + (size_t)row * DM; mr = row >> 12; }
        else { src = (first ? a.in[I_XS] : a.out + O_YS) + (size_t)(row - MROWS) * DM; mr = NB + row - MROWS; }
        const float* mp = mod + (size_t)(l * NMOD + mr) * MODW + (which ? 3 * DM : 0);
        f32x4 v[4]; float ss = 0.f;
#pragma unroll
        for (int j = 0; j < 4; ++j) { v[j] = *(const f32x4*)(src + 256 * j + 4 * lane); ss += (v[j].x * v[j].x + v[j].y * v[j].y) + (v[j].z * v[j].z + v[j].w * v[j].w); }
        const float rstd = 1.0f / sqrtf(wave_sum(ss) * (1.0f / DM) + EPS);
#pragma unroll
        for (int j = 0; j < 4; ++j) { const int col = 256 * j + 4 * lane;
            const f32x4 gn = *(const f32x4*)(gain + col), sh = *(const f32x4*)(mp + col), sc = *(const f32x4*)(mp + DM + col);
            const f32x4 o = (v[j] * rstd * gn) * (sc + 1.0f) + sh;
            u32x2 w; w.x = cvtpk(o.x, o.y); w.y = cvtpk(o.z, o.w);
            *(u32x2*)(H + (size_t)row * DM + col) = w; }
    }
}

struct EpiIn {
    static constexpr bool PERM = true, AFTER_DRAIN = false;
    bf16 *U, *Q, *K, *V, *GP, *GA; const float *qg, *kg, *rope; float* out; int l;
    __device__ __forceinline__ void operator()(const pg8::f32x4 (&acc)[2][2][4][2], const pg8::Unit& u, int wr, int wc, int fr, int fq) const {
        const int pn = u.pn, row0 = u.pm * 256 + wr * 64 + fr;
        if (pn < 2) {
#pragma unroll
            for (int ai = 0; ai < 2; ++ai)
#pragma unroll
                for (int m = 0; m < 4; ++m) { const int row = row0 + ai * 128 + m * 16, t = row & (SEQ - 1), b = row >> 12;
#pragma unroll
                    for (int bj = 0; bj < 2; ++bj) { const int col = pn * 256 + bj * 128 + wc * 32 + 8 * fq; const pg8::f32x4 v0 = acc[ai][bj][m][0], v1 = acc[ai][bj][m][1];
                        v4u w; w.x = cvtpk(v0[0], v0[1]); w.y = cvtpk(v0[2], v0[3]); w.z = cvtpk(v1[0], v1[1]); w.w = cvtpk(v1[2], v1[3]);
                        *(v4u*)(U + (size_t)row * PW + col) = w;
                        if (t >= SEQ - 15) { float* o = out + O_POOLP + ((size_t)(l * NB + b) * 15 + (t - (SEQ - 15))) * PW + col; *(pg8::f32x4*)o = v0; *(pg8::f32x4*)(o + 4) = v1; } } }
        } else if (pn < 8) {
            const bool isk = pn >= 5; const int g = pn - (isk ? 5 : 2), head = 4 * g + wc, W = 128 << (2 * g);
            const float* gn = isk ? kg : qg;
            pg8::f32x4 gv[2][2];
#pragma unroll
            for (int bj = 0; bj < 2; ++bj)
#pragma unroll
                for (int n = 0; n < 2; ++n) gv[bj][n] = *(const pg8::f32x4*)(gn + 32 * bj + 8 * fq + 4 * n);
            bf16* dstb = (isk ? K : Q) + head * 64 + 8 * fq;
            float* ko = out + (g == 0 ? O_KP0 : g == 1 ? O_KP1 : O_KP2);
#pragma unroll
            for (int ai = 0; ai < 2; ++ai)
#pragma unroll
                for (int m = 0; m < 4; ++m) { const int row = row0 + ai * 128 + m * 16, t = row & (SEQ - 1), b = row >> 12;
                    float ss = 0.f;
#pragma unroll
                    for (int bj = 0; bj < 2; ++bj)
#pragma unroll
                        for (int n = 0; n < 2; ++n) { const pg8::f32x4 v = acc[ai][bj][m][n]; ss += (v[0] * v[0] + v[1] * v[1]) + (v[2] * v[2] + v[3] * v[3]); }
                    ss += shx<16>(ss); ss = sum32(ss);
                    const float rstd = 1.0f / sqrtf(ss * (1.0f / 64.0f) + EPS);
                    pg8::f32x4 o1[2], o2[2];
#pragma unroll
                    for (int n = 0; n < 2; ++n) { const pg8::f32x4 y1 = acc[ai][0][m][n] * rstd * gv[0][n], y2 = acc[ai][1][m][n] * rstd * gv[1][n];
                        const float* rp = rope + ((size_t)t * 32 + 8 * fq + 4 * n) * 2; const pg8::f32x4 ra = *(const pg8::f32x4*)rp, rb = *(const pg8::f32x4*)(rp + 4);
                        const pg8::f32x4 cs = {ra[0], ra[2], rb[0], rb[2]}, sn = {ra[1], ra[3], rb[1], rb[3]};
                        o1[n] = y1 * cs - y2 * sn; o2[n] = y2 * cs + y1 * sn; }
                    if (!isk) { o1[0] *= C2; o1[1] *= C2; o2[0] *= C2; o2[1] *= C2; }
                    v4u w1, w2; w1.x = cvtpk(o1[0][0], o1[0][1]); w1.y = cvtpk(o1[0][2], o1[0][3]); w1.z = cvtpk(o1[1][0], o1[1][1]); w1.w = cvtpk(o1[1][2], o1[1][3]);
                    w2.x = cvtpk(o2[0][0], o2[0][1]); w2.y = cvtpk(o2[0][2], o2[0][3]); w2.z = cvtpk(o2[1][0], o2[1][1]); w2.w = cvtpk(o2[1][2], o2[1][3]);
                    *(v4u*)(dstb + (size_t)row * AW) = w1; *(v4u*)(dstb + (size_t)row * AW + 32) = w2;
                    if (isk && t >= SEQ - W) { float* o = ko + ((size_t)(l * NB + b) * W + (t - (SEQ - W))) * 256 + wc * 64 + 8 * fq;
                        *(pg8::f32x4*)o = o1[0]; *(pg8::f32x4*)(o + 4) = o1[1]; *(pg8::f32x4*)(o + 32) = o2[0]; *(pg8::f32x4*)(o + 36) = o2[1]; } }
        } else if (pn < 11) {
            const int g = pn - 8, W = 128 << (2 * g);
            float* vo = out + (g == 0 ? O_VP0 : g == 1 ? O_VP1 : O_VP2);
#pragma unroll
            for (int ai = 0; ai < 2; ++ai)
#pragma unroll
                for (int m = 0; m < 4; ++m) { const int row = row0 + ai * 128 + m * 16, t = row & (SEQ - 1), b = row >> 12;
#pragma unroll
                    for (int bj = 0; bj < 2; ++bj) { const int cl = bj * 128 + wc * 32 + 8 * fq; const pg8::f32x4 v0 = acc[ai][bj][m][0], v1 = acc[ai][bj][m][1];
                        v4u w; w.x = cvtpk(v0[0], v0[1]); w.y = cvtpk(v0[2], v0[3]); w.z = cvtpk(v1[0], v1[1]); w.w = cvtpk(v1[2], v1[3]);
                        *(v4u*)(V + (size_t)row * AW + g * 256 + cl) = w;
                        if (t >= SEQ - W) { float* o = vo + ((size_t)(l * NB + b) * W + (t - (SEQ - W))) * 256 + cl; *(pg8::f32x4*)o = v0; *(pg8::f32x4*)(o + 4) = v1; } } }
        } else {
            bf16* dst = pn < 15 ? GP + (pn - 11) * 256 : GA + (pn - 15) * 256;
#pragma unroll
            for (int ai = 0; ai < 2; ++ai)
#pragma unroll
                for (int m = 0; m < 4; ++m) { const int row = row0 + ai * 128 + m * 16;
#pragma unroll
                    for (int bj = 0; bj < 2; ++bj) { const int cl = bj * 128 + wc * 32 + 8 * fq; const pg8::f32x4 v0 = acc[ai][bj][m][0], v1 = acc[ai][bj][m][1];
                        v4u w; w.x = cvtpk(sigmoidf_(v0[0]), sigmoidf_(v0[1])); w.y = cvtpk(sigmoidf_(v0[2]), sigmoidf_(v0[3])); w.z = cvtpk(sigmoidf_(v1[0]), sigmoidf_(v1[1])); w.w = cvtpk(sigmoidf_(v1[2]), sigmoidf_(v1[3]));
                        *(v4u*)(dst + (size_t)row * DM + cl) = w; } }
        }
    }
};
template <int MODE> struct EpiEw {
    static constexpr bool PERM = true, AFTER_DRAIN = false;
    const bf16* G; const bf16* Tin; bf16* O; int ldc;
    __device__ __forceinline__ void operator()(const pg8::f32x4 (&acc)[2][2][4][2], const pg8::Unit& u, int wr, int wc, int fr, int fq) const {
        const int row0 = u.pm * 256 + wr * 64 + fr, col0 = u.pn * 256 + wc * 32 + 8 * fq;
#pragma unroll
        for (int ai = 0; ai < 2; ++ai)
#pragma unroll
            for (int m = 0; m < 4; ++m) { const size_t ro = (size_t)(row0 + ai * 128 + m * 16) * ldc + col0;
#pragma unroll
                for (int bj = 0; bj < 2; ++bj) { const size_t off = ro + bj * 128; const pg8::f32x4 a0 = acc[ai][bj][m][0], a1 = acc[ai][bj][m][1];
                    float r[8] = {a0[0], a0[1], a0[2], a0[3], a1[0], a1[1], a1[2], a1[3]};
                    if (MODE == 0 || MODE == 1) { const v4u gw = *(const v4u*)(G + off); const unsigned gq[4] = {gw.x, gw.y, gw.z, gw.w};
#pragma unroll
                        for (int q = 0; q < 4; ++q) { r[2 * q] *= bf_lo(gq[q]); r[2 * q + 1] *= bf_hi(gq[q]); } }
                    if (MODE == 1) { const v4u tw = *(const v4u*)(Tin + off); const unsigned tq[4] = {tw.x, tw.y, tw.z, tw.w};
#pragma unroll
                        for (int q = 0; q < 4; ++q) { r[2 * q] += bf_lo(tq[q]); r[2 * q + 1] += bf_hi(tq[q]); } }
                    if (MODE == 2) {
#pragma unroll
                        for (int q = 0; q < 8; ++q) { const float x = fmaxf(r[q], 0.f); r[q] = x * x; } }
                    v4u w; w.x = cvtpk(r[0], r[1]); w.y = cvtpk(r[2], r[3]); w.z = cvtpk(r[4], r[5]); w.w = cvtpk(r[6], r[7]);
                    *(v4u*)(O + off) = w; }
                if (MODE != 2) asm volatile("" ::: "memory"); }
    }
};
struct EpiRes {
    static constexpr bool PERM = false, AFTER_DRAIN = false;
    const float* base; float* outp; const float* gate;
    __device__ __forceinline__ void operator()(const pg8::f32x4 (&acc)[2][2][4][2], const pg8::Unit& u, int wr, int wc, int fr, int fq) const {
        const int row0 = u.pm * 256 + wr * 64 + fr, col0 = u.pn * 256 + wc * 32 + 4 * fq, b = (u.pm * 256) >> 12;
        pg8::f32x4 gv[2][2];
#pragma unroll
        for (int bj = 0; bj < 2; ++bj)
#pragma unroll
            for (int n = 0; n < 2; ++n) gv[bj][n] = *(const pg8::f32x4*)(gate + (size_t)b * MODW + col0 + bj * 128 + n * 16);
#pragma unroll
        for (int ai = 0; ai < 2; ++ai)
#pragma unroll
            for (int m = 0; m < 4; ++m) { const size_t ro = (size_t)(row0 + ai * 128 + m * 16) * DM + col0;
#pragma unroll
                for (int bj = 0; bj < 2; ++bj)
#pragma unroll
                    for (int n = 0; n < 2; ++n) { const size_t off = ro + bj * 128 + n * 16; *(pg8::f32x4*)(outp + off) = *(const pg8::f32x4*)(base + off) + gv[bj][n] * acc[ai][bj][m][n]; } }
    }
};

template <int W> __device__ __forceinline__ void pool_item(const bf16* U, bf16* PA, int b, int t0, int gi, int lane) {
    const unsigned* up = (const unsigned*)(U + (size_t)b * SEQ * PW + 128 * gi) + lane;
    float x0[32 + W - 1], x1[32 + W - 1];
#pragma unroll
    for (int i = 0; i < 32 + W - 1; ++i) { const int t = t0 - (W - 1) + i; const unsigned w = t >= 0 ? up[(size_t)t * (PW / 2)] : 0u; x0[i] = bf_lo(w); x1[i] = bf_hi(w); }
    unsigned* pp = (unsigned*)(PA + ((size_t)b * SEQ + t0) * AW + 128 * gi) + lane;
#pragma unroll
    for (int o = 0; o < 32; ++o) { const int t = t0 + o; float s0 = 0.f, s1 = 0.f;
#pragma unroll
        for (int i = 0; i < W; ++i) { s0 += x0[o + i]; s1 += x1[o + i]; }
        const int cnt = (t + 1 < W) ? (t + 1) : W; const float rc = 1.0f / (float)cnt;
        pp[(size_t)o * (AW / 2)] = cvtpk(s0 * rc - x0[o + W - 1], s1 * rc - x1[o + W - 1]); }
}

constexpr int AT_ORUN = 0, AT_OPITCH = 68, AT_M = 256 * AT_OPITCH * 4, AT_L = AT_M + 1024, AT_VST = 73728;
__device__ __forceinline__ int vst_off(int row, int ch) { return row * 128 + ((ch ^ (((row >> 1) & 3) << 1)) << 4); }
__device__ __forceinline__ void attn_unit(LAS unsigned char* lds, const bf16* Q, const bf16* K, const bf16* V, bf16* PA, int b, int j, int pb, int wave, int lane) {
    LAS float* Orun = (LAS float*)(lds + AT_ORUN); LAS float* mrun = (LAS float*)(lds + AT_M); LAS float* lrun = (LAS float*)(lds + AT_L);
    LAS unsigned char* vst = lds + AT_VST + wave * 8192;
    const int fr = lane & 15, fq = lane >> 4, T0 = pb * 256;
    const size_t rb = (size_t)b * SEQ;
    const float NEG_INF = -__builtin_inff();
    int wo[4], ro[2][4];
#pragma unroll
    for (int i = 0; i < 4; ++i) wo[i] = vst_off((lane >> 3) + 8 * i, lane & 7);
#pragma unroll
    for (int t = 0; t < 2; ++t)
#pragma unroll
        for (int c = 0; c < 4; ++c) ro[t][c] = vst_off(16 * t + 4 * fq + (fr >> 2), 2 * c + ((fr & 3) >> 1)) + 8 * (fr & 1);
#pragma unroll
    for (int g = 0; g < 3; ++g) {
        const int dsh = 2 * g, head = 4 * g + j;
        for (int it2 = 0; it2 < 2; ++it2) {
            const int item = wave * 2 + it2, r = item & ((1 << dsh) - 1), cblk = item >> dsh, i0 = (T0 >> dsh) + 16 * cblk;
            int kbmin = (128 - i0) >> 4; kbmin = kbmin < 0 ? 0 : kbmin;
            const int qpos = ((i0 + fr) << dsh) + r;
            const bf16* qp = Q + (rb + qpos) * AW + head * 64 + 8 * fq;
            const bf16* kp = K + (rb + (size_t)((i0 - 128 + fr) * (1 << dsh) + r)) * AW + head * 64 + 8 * fq;
            const bf16* vp = V + (rb + (size_t)((i0 - 128 + (lane >> 3)) * (1 << dsh) + r)) * AW + head * 64 + 8 * (lane & 7);
            const size_t kstride = (size_t)(16 << dsh) * AW;
            const bf16x8 q0 = *(const bf16x8*)qp, q1 = *(const bf16x8*)(qp + 32);
            bf16x8 kf[9][2];
#pragma unroll
            for (int kb = 0; kb < 9; ++kb) { const int kbc = kb < kbmin ? kbmin : kb; kf[kb][0] = *(const bf16x8*)(kp + kbc * kstride); kf[kb][1] = *(const bf16x8*)(kp + kbc * kstride + 32); }
            v4u vr[5][4];
#pragma unroll
            for (int pp = 0; pp < 5; ++pp)
#pragma unroll
                for (int i = 0; i < 4; ++i) { int kbx = 2 * pp + (i >> 1); kbx = kbx > 8 ? 8 : kbx; kbx = kbx < kbmin ? kbmin : kbx;
                    vr[pp][i] = *(const v4u*)(vp + kbx * kstride + (size_t)((8 * (i & 1)) << dsh) * AW); }
            f32x4 S[9];
#pragma unroll
            for (int kb = 0; kb < 9; ++kb) { f32x4 z = {0.f, 0.f, 0.f, 0.f};
                z = __builtin_amdgcn_mfma_f32_16x16x32_bf16(kf[kb][0], q0, z, 0, 0, 0);
                S[kb] = __builtin_amdgcn_mfma_f32_16x16x32_bf16(kf[kb][1], q1, z, 0, 0, 0); }
            float mx = NEG_INF;
#pragma unroll
            for (int kb = 0; kb < 9; ++kb) { const bool bv = kb >= kbmin;
#pragma unroll
                for (int e = 0; e < 4; ++e) { const int m = 4 * fq + e; const bool ok = bv && (kb == 0 ? (m >= fr) : (kb == 8 ? (m <= fr) : true));
                    S[kb][e] = ok ? S[kb][e] : NEG_INF; mx = fmaxf(mx, S[kb][e]); } }
            mx = fmaxf(mx, shx<16>(mx)); mx = max32(mx);
            float ls = 0.f;
#pragma unroll
            for (int kb = 0; kb < 9; ++kb)
#pragma unroll
                for (int e = 0; e < 4; ++e) { const float p = __builtin_amdgcn_exp2f(S[kb][e] - mx); S[kb][e] = p; ls += p; }
            ls += shx<16>(ls); ls = sum32(ls);
            f32x4 O[4];
#pragma unroll
            for (int c = 0; c < 4; ++c) O[c] = (f32x4){0.f, 0.f, 0.f, 0.f};
#pragma unroll
            for (int pp = 0; pp < 5; ++pp) {
                LAS unsigned char* vb = vst + (pp & 1) * 4096;
#pragma unroll
                for (int i = 0; i < 4; ++i) *(LAS v4u*)(vb + wo[i]) = vr[pp][i];
                const int kb0 = 2 * pp, kb1 = (2 * pp + 1 > 8) ? 8 : 2 * pp + 1;
                v4u pw; pw.x = cvtpk(S[kb0][0], S[kb0][1]); pw.y = cvtpk(S[kb0][2], S[kb0][3]);
                if (2 * pp + 1 <= 8) { pw.z = cvtpk(S[kb1][0], S[kb1][1]); pw.w = cvtpk(S[kb1][2], S[kb1][3]); } else { pw.z = 0u; pw.w = 0u; }
                const bf16x8 Pf = __builtin_bit_cast(bf16x8, pw);
#pragma unroll
                for (int c = 0; c < 4; ++c) {
                    const s16x4 lo = __builtin_bit_cast(s16x4, __builtin_amdgcn_ds_read_tr16_b64_v4i16((LAS s16x4*)(vb + ro[0][c])));
                    const s16x4 hi = __builtin_bit_cast(s16x4, __builtin_amdgcn_ds_read_tr16_b64_v4i16((LAS s16x4*)(vb + ro[1][c])));
                    const bf16x8 Vf = {lo[0], lo[1], lo[2], lo[3], hi[0], hi[1], hi[2], hi[3]};
                    O[c] = __builtin_amdgcn_mfma_f32_16x16x32_bf16(Vf, Pf, O[c], 0, 0, 0); }
            }
            const int ql = qpos - T0;
            LAS float* orow = Orun + ql * AT_OPITCH + 4 * fq;
            if (g == 0) {
#pragma unroll
                for (int c = 0; c < 4; ++c) *(LAS f32x4*)(orow + 16 * c) = O[c];
                if (fq == 0) { mrun[ql] = mx; lrun[ql] = ls; }
            } else {
                const float mo = mrun[ql], lo = lrun[ql], mn = fmaxf(mo, mx), fa = __builtin_amdgcn_exp2f(mo - mn), fb = __builtin_amdgcn_exp2f(mx - mn), ln = fa * lo + fb * ls;
                if (g == 1) {
#pragma unroll
                    for (int c = 0; c < 4; ++c) { const f32x4 oo = *(const LAS f32x4*)(orow + 16 * c); *(LAS f32x4*)(orow + 16 * c) = oo * fa + O[c] * fb; }
                    if (fq == 0) { mrun[ql] = mn; lrun[ql] = ln; }
                } else {
                    const float inv = 1.0f / ln;
                    bf16* op = PA + (rb + qpos) * AW + PW + j * 64 + 4 * fq;
#pragma unroll
                    for (int c = 0; c < 4; ++c) { const f32x4 oo = *(const LAS f32x4*)(orow + 16 * c); const f32x4 rr = (oo * fa + O[c] * fb) * inv;
                        u32x2 w; w.x = cvtpk(rr[0], rr[1]); w.y = cvtpk(rr[2], rr[3]); *(u32x2*)(op + 16 * c) = w; }
                }
            }
        }
        __syncthreads();
    }
}

__device__ __forceinline__ void sample_attn_wg(const Args& a, LAS unsigned char* lds, int l, int b, int hh, int wave, int lane) {
    const float* sm = (const float*)(a.ws + WS_SMALL);
    const int dl = lane & 15, ks = lane >> 4;
    float mrun = -__builtin_inff(), lrun = 0.f; f32x4 orun = {0.f, 0.f, 0.f, 0.f};
#pragma unroll
    for (int g = 0; g < 3; ++g) {
        const int hist = 128 << (2 * g), dil = 1 << (2 * g), head = 4 * g + hh;
        const float* ck = a.in[I_CK0 + 2 * g] + ((size_t)(l * SB + b) * hist) * 256 + hh * 64 + 4 * dl;
        const float* cv = a.in[I_CV0 + 2 * g] + ((size_t)(l * SB + b) * hist) * 256 + hh * 64 + 4 * dl;
        const f32x4 q = *(const f32x4*)(sm + SM_QS + b * AW + head * 64 + 4 * dl);
        const float* knew = sm + SM_KS + b * AW + head * 64 + 4 * dl; const float* vnew = sm + SM_VS + b * AW + head * 64 + 4 * dl;
        f32x4 kv[5], vv[5];
#pragma unroll
        for (int s5 = 0; s5 < 5; ++s5) { const int jk = 4 * (wave + 8 * s5) + ks; const int jc = jk <= 128 ? jk : 128;
            const size_t ro = (size_t)(hist - dil * jc) * 256;
            const float* kptr = (jc == 0) ? knew : ck + ro; const float* vptr = (jc == 0) ? vnew : cv + ro;
            kv[s5] = *(const f32x4*)kptr; vv[s5] = *(const f32x4*)vptr; }
#pragma unroll
        for (int s5 = 0; s5 < 5; ++s5) { const int jk = 4 * (wave + 8 * s5) + ks; const bool ok = jk <= 128;
            float d = (kv[s5].x * q.x + kv[s5].y * q.y) + (kv[s5].z * q.z + kv[s5].w * q.w);
            d += shx<1>(d); d += shx<2>(d); d += shx<4>(d); d += shx<8>(d);
            d = ok ? d : -__builtin_inff();
            const float mn = fmaxf(mrun, d), fa = __builtin_amdgcn_exp2f(mrun - mn), p = __builtin_amdgcn_exp2f(d - mn);
            lrun = lrun * fa + p; orun = orun * fa + vv[s5] * p; mrun = mn; }
    }
    float mall = fmaxf(mrun, shx<16>(mrun)); mall = max32(mall);
    const float sc = __builtin_amdgcn_exp2f(mrun - mall);
    lrun *= sc; orun *= sc;
    lrun += shx<16>(lrun); lrun = sum32(lrun);
#pragma unroll
    for (int e = 0; e < 4; ++e) { orun[e] += shx<16>(orun[e]); orun[e] = sum32(orun[e]); }
    LAS float* part = (LAS float*)lds;
    __syncthreads();
    if (ks == 0) { *(LAS f32x4*)(part + wave * 64 + 4 * dl) = orun; if (dl == 0) { part[512 + wave] = mall; part[520 + wave] = lrun; } }
    __syncthreads();
    if (wave == 0 && ks == 0) {
        float M = -__builtin_inff();
#pragma unroll
        for (int w = 0; w < 8; ++w) M = fmaxf(M, part[512 + w]);
        f32x4 o = {0.f, 0.f, 0.f, 0.f}; float lt = 0.f;
#pragma unroll
        for (int w = 0; w < 8; ++w) { const float f = __builtin_amdgcn_exp2f(part[512 + w] - M); o += *(const LAS f32x4*)(part + w * 64 + 4 * dl) * f; lt += part[520 + w] * f; }
        const float inv = 1.0f / lt; bf16* op = (bf16*)(a.ws + WS_PA) + (size_t)(MROWS + b) * AW + PW + hh * 64 + 4 * dl;
        u32x2 w2; w2.x = cvtpk(o[0] * inv, o[1] * inv); w2.y = cvtpk(o[2] * inv, o[3] * inv); *(u32x2*)op = w2; }
}
__device__ __forceinline__ void sample_pool_item(const Args& a, int l, int b, int lane) {
    const float* us = (const float*)(a.ws + WS_SMALL) + SM_US + b * PW + 8 * lane;
    const float* st = a.in[I_STATE] + (size_t)(l * SB + b) * 15 * PW + 8 * lane;
    const int W = 2 << (lane >> 4);
    const f32x4 u0 = *(const f32x4*)us, u1 = *(const f32x4*)(us + 4); f32x4 s0 = u0, s1 = u1;
    for (int i = 1; i < W; ++i) { s0 += *(const f32x4*)(st + (size_t)(15 - i) * PW); s1 += *(const f32x4*)(st + (size_t)(15 - i) * PW + 4); }
    const float rc = 1.0f / (float)W; const f32x4 p0 = s0 * rc - u0, p1 = s1 * rc - u1;
    v4u w; w.x = cvtpk(p0[0], p0[1]); w.y = cvtpk(p0[2], p0[3]); w.z = cvtpk(p1[0], p1[1]); w.w = cvtpk(p1[2], p1[3]);
    *(v4u*)((bf16*)(a.ws + WS_PA) + (size_t)(MROWS + b) * AW + 8 * lane) = w;
}

template <int K> __device__ __forceinline__ f32x4 thin_tile(LAS unsigned char* lds, const bf16* A, int lda, const bf16* Bt, int ldb, int cb0, int cb1, int cb2, int cb3, int tid, int wave, int lane) {
    constexpr int kw = K / 8, NS = kw / 32, NB_ = NS < 4 ? NS : 4;
    const int fr = lane & 15, fq = lane >> 4;
    f32x4 acc[2][4];
#pragma unroll
    for (int mb = 0; mb < 2; ++mb)
#pragma unroll
        for (int nb = 0; nb < 4; ++nb) acc[mb][nb] = (f32x4){0.f, 0.f, 0.f, 0.f};
    const bf16* ap = A + (size_t)fr * lda + wave * kw + 8 * fq;
    const bf16* bp0 = Bt + (size_t)(cb0 + fr) * ldb + wave * kw + 8 * fq; const bf16* bp1 = Bt + (size_t)(cb1 + fr) * ldb + wave * kw + 8 * fq;
    const bf16* bp2 = Bt + (size_t)(cb2 + fr) * ldb + wave * kw + 8 * fq; const bf16* bp3 = Bt + (size_t)(cb3 + fr) * ldb + wave * kw + 8 * fq;
    for (int k0 = 0; k0 < kw; k0 += 32 * NB_) {
        bf16x8 a0[NB_], a1[NB_], b0[NB_], b1[NB_], b2[NB_], b3[NB_];
#pragma unroll
        for (int s = 0; s < NB_; ++s) { const int k = k0 + 32 * s;
            a0[s] = *(const bf16x8*)(ap + k); a1[s] = *(const bf16x8*)(ap + (size_t)16 * lda + k);
            b0[s] = *(const bf16x8*)(bp0 + k); b1[s] = *(const bf16x8*)(bp1 + k); b2[s] = *(const bf16x8*)(bp2 + k); b3[s] = *(const bf16x8*)(bp3 + k); }
#pragma unroll
        for (int s = 0; s < NB_; ++s) {
            acc[0][0] = __builtin_amdgcn_mfma_f32_16x16x32_bf16(b0[s], a0[s], acc[0][0], 0, 0, 0); acc[1][0] = __builtin_amdgcn_mfma_f32_16x16x32_bf16(b0[s], a1[s], acc[1][0], 0, 0, 0);
            acc[0][1] = __builtin_amdgcn_mfma_f32_16x16x32_bf16(b1[s], a0[s], acc[0][1], 0, 0, 0); acc[1][1] = __builtin_amdgcn_mfma_f32_16x16x32_bf16(b1[s], a1[s], acc[1][1], 0, 0, 0);
            acc[0][2] = __builtin_amdgcn_mfma_f32_16x16x32_bf16(b2[s], a0[s], acc[0][2], 0, 0, 0); acc[1][2] = __builtin_amdgcn_mfma_f32_16x16x32_bf16(b2[s], a1[s], acc[1][2], 0, 0, 0);
            acc[0][3] = __builtin_amdgcn_mfma_f32_16x16x32_bf16(b3[s], a0[s], acc[0][3], 0, 0, 0); acc[1][3] = __builtin_amdgcn_mfma_f32_16x16x32_bf16(b3[s], a1[s], acc[1][3], 0, 0, 0); }
    }
    LAS float* red = (LAS float*)lds;
    __syncthreads();
#pragma unroll
    for (int mb = 0; mb < 2; ++mb)
#pragma unroll
        for (int nb = 0; nb < 4; ++nb) *(LAS f32x4*)(red + (wave * 32 + 16 * mb + fr) * 64 + 16 * nb + 4 * fq) = acc[mb][nb];
    __syncthreads();
    const int row = tid >> 4, c4 = 4 * (tid & 15);
    f32x4 s = {0.f, 0.f, 0.f, 0.f};
#pragma unroll
    for (int w = 0; w < 8; ++w) s += *(const LAS f32x4*)(red + (w * 32 + row) * 64 + c4);
    return s;
}

#define THIN_FOR(ui, n) for (int ui = G - 1 - c; ui < (n); ui += G)

__device__ __forceinline__ void thin_in(const Args& a, LAS unsigned char* lds, int l, int c, int G, int tid, int wave, int lane) {
    const bf16* H = (const bf16*)(a.ws + WS_H) + (size_t)MROWS * DM; const bf16* Wt = (const bf16*)(a.ws + WS_W + (size_t)l * W_LAYER + WO_IN);
    float* sm = (float*)(a.ws + WS_SMALL); const float* rope = (const float*)(a.ws + WS_ROPE) + (size_t)4096 * 64;
    THIN_FOR(ui, 76) {
        int cb[4];
        const bool isq = ui >= 8 && ui < 20, isk = ui >= 20 && ui < 32;
        if (isq || isk) { const int hq = ui - (isq ? 8 : 20), tile = (isq ? 2 : 5) + (hq >> 2), wc = hq & 3;
#pragma unroll
            for (int nb = 0; nb < 4; ++nb) cb[nb] = tile * 256 + 128 * (nb >> 1) + 32 * wc + 16 * (nb & 1);
        } else {
#pragma unroll
            for (int nb = 0; nb < 4; ++nb) cb[nb] = 64 * ui + 16 * nb; }
        const f32x4 v = thin_tile<DM>(lds, H, DM, Wt, DM, cb[0], cb[1], cb[2], cb[3], tid, wave, lane);
        const int b = tid >> 4, c4 = 4 * (tid & 15);
        if (ui < 8) { const int col = 64 * ui + c4;
            *(f32x4*)(sm + SM_US + b * PW + col) = v; *(f32x4*)(a.out + O_POOLS + ((size_t)(l * SB + b) * 15 + 14) * PW + col) = v;
        } else if (ui < 32) { const int hq = ui - (isq ? 8 : 20), g = hq >> 2, hh = hq & 3;
            float ss = (v[0] * v[0] + v[1] * v[1]) + (v[2] * v[2] + v[3] * v[3]);
            ss += shx<1>(ss); ss += shx<2>(ss); ss += shx<4>(ss); ss += shx<8>(ss);
            const float rstd = 1.0f / sqrtf(ss * (1.0f / 64.0f) + EPS);
            const f32x4 gn = *(const f32x4*)(a.in[isq ? I_QG : I_KG] + l * 64 + c4);
            const f32x4 y = v * rstd * gn;
            f32x4 yp; yp[0] = shx<8>(y[0]); yp[1] = shx<8>(y[1]); yp[2] = shx<8>(y[2]); yp[3] = shx<8>(y[3]);
            const int i0 = c4 & 31; const float* rp = rope + 2 * i0; const f32x4 ra = *(const f32x4*)rp, rb = *(const f32x4*)(rp + 4);
            const f32x4 cs = {ra[0], ra[2], rb[0], rb[2]}, sn = {ra[1], ra[3], rb[1], rb[3]};
            f32x4 o = (c4 < 32) ? (y * cs - yp * sn) : (y * cs + yp * sn);
            if (isq) { o *= C2; *(f32x4*)(sm + SM_QS + b * AW + hq * 64 + c4) = o; }
            else { *(f32x4*)(sm + SM_KS + b * AW + hq * 64 + c4) = o;
                *(f32x4*)(a.out + (g == 0 ? O_KS0 : g == 1 ? O_KS1 : O_KS2) + (size_t)(l * SB + b) * 256 + hh * 64 + c4) = o; }
        } else if (ui < 44) { const int hq = ui - 32, g = hq >> 2, hh = hq & 3;
            *(f32x4*)(sm + SM_VS + b * AW + hq * 64 + c4) = v;
            *(f32x4*)(a.out + (g == 0 ? O_VS0 : g == 1 ? O_VS1 : O_VS2) + (size_t)(l * SB + b) * 256 + hh * 64 + c4) = v;
        } else { const int col = 64 * (ui - (ui < 60 ? 44 : 60)) + c4; const f32x4 sg = {sigmoidf_(v[0]), sigmoidf_(v[1]), sigmoidf_(v[2]), sigmoidf_(v[3])};
            *(f32x4*)(sm + (ui < 60 ? SM_GP : SM_GA) + b * DM + col) = sg; }
    }
}
__device__ __forceinline__ void thin_gate(const Args& a, LAS unsigned char* lds, int l, int c, int G, int tid, int wave, int lane) {
    const bf16* PAs = (const bf16*)(a.ws + WS_PA) + (size_t)MROWS * AW; const bf16* Wc = (const bf16*)(a.ws + WS_W + (size_t)l * W_LAYER + WO_CAT);
    const float* sm = (const float*)(a.ws + WS_SMALL); bf16* MG = (bf16*)(a.ws + WS_MG) + (size_t)MROWS * DM;
    THIN_FOR(ui, 16) { const int n0 = 64 * ui;
        const f32x4 v1 = thin_tile<PW>(lds, PAs, AW, Wc, 768, n0, n0 + 16, n0 + 32, n0 + 48, tid, wave, lane);
        const f32x4 v2 = thin_tile<AO>(lds, PAs + PW, AW, Wc + PW, 768, n0, n0 + 16, n0 + 32, n0 + 48, tid, wave, lane);
        const int b = tid >> 4, col = n0 + 4 * (tid & 15);
        const f32x4 gp = *(const f32x4*)(sm + SM_GP + b * DM + col), ga = *(const f32x4*)(sm + SM_GA + b * DM + col);
        const f32x4 o = gp * v1 + ga * v2; u32x2 w; w.x = cvtpk(o[0], o[1]); w.y = cvtpk(o[2], o[3]);
        *(u32x2*)(MG + (size_t)b * DM + col) = w; }
}
__device__ __forceinline__ void thin_res(const Args& a, LAS unsigned char* lds, int l, int which, int c, int G, int tid, int wave, int lane, bool dummy = false) {
    const bf16* A = which ? (const bf16*)(a.ws + WS_UP) + (size_t)MROWS * FF : (const bf16*)(a.ws + WS_MG) + (size_t)MROWS * DM;
    const bf16* Wt = (const bf16*)(a.ws + WS_W + (size_t)l * W_LAYER + (which ? WO_DN : WO_OUT));
    const float* gate = (const float*)(a.ws + WS_MOD) + (size_t)(l * NMOD + NB) * MODW + (which ? 5 : 2) * DM;
    const float* base = (l == 0 && which == 0) ? a.in[I_XS] : a.out + O_YS;
    THIN_FOR(ui, 16) { const int n0 = 64 * ui;
        const f32x4 v = which ? thin_tile<FF>(lds, A, FF, Wt, FF, n0, n0 + 16, n0 + 32, n0 + 48, tid, wave, lane) : thin_tile<DM>(lds, A, DM, Wt, DM, n0, n0 + 16, n0 + 32, n0 + 48, tid, wave, lane);
        const int b = tid >> 4, col = n0 + 4 * (tid & 15);
        const f32x4 gt = *(const f32x4*)(gate + (size_t)b * MODW + col), xb = *(const f32x4*)(base + b * DM + col);
        float* dstp = dummy ? (float*)(a.ws + WS_T) : a.out + O_YS;
        *(f32x4*)(dstp + b * DM + col) = xb + gt * v; }
}
__device__ __forceinline__ void thin_up(const Args& a, LAS unsigned char* lds, int l, int c, int G, int tid, int wave, int lane) {
    const bf16* H = (const bf16*)(a.ws + WS_H) + (size_t)MROWS * DM; const bf16* Wt = (const bf16*)(a.ws + WS_W + (size_t)l * W_LAYER + WO_UP);
    bf16* UPs = (bf16*)(a.ws + WS_UP) + (size_t)MROWS * FF;
    THIN_FOR(ui, 64) { const int n0 = 64 * ui;
        const f32x4 v = thin_tile<DM>(lds, H, DM, Wt, DM, n0, n0 + 16, n0 + 32, n0 + 48, tid, wave, lane);
        const int b = tid >> 4, col = n0 + 4 * (tid & 15);
        const float r0 = fmaxf(v[0], 0.f), r1 = fmaxf(v[1], 0.f), r2 = fmaxf(v[2], 0.f), r3 = fmaxf(v[3], 0.f);
        u32x2 w; w.x = cvtpk(r0 * r0, r1 * r1); w.y = cvtpk(r2 * r2, r3 * r3);
        *(u32x2*)(UPs + (size_t)b * FF + col) = w; }
}

#ifndef PHMASK
#define PHMASK 0xffffffffu
#endif
#define PH(k) ((PHMASK >> (k)) & 1u)
#ifndef DUPMASK
#define DUPMASK 0u
#endif
#define REPK(k) (1 + (int)((DUPMASK >> (k)) & 1u))
#define FRESH(t, ln, wv, gwv) int t = threadIdx.x; asm volatile("" : "+v"(t)); const int ln = t & 63, wv = __builtin_amdgcn_readfirstlane(t >> 6), gwv = c * NWAVES + wv; (void)ln; (void)gwv;
#ifndef N_LAYERS_RUN
#define N_LAYERS_RUN DEPTH
#endif
__global__ void __launch_bounds__(NTHREADS, 2) fwd(Args a) {
    extern __shared__ __attribute__((aligned(16))) unsigned char lds_raw[];
    LAS unsigned char* lds = (LAS unsigned char*)lds_raw;
    const int tid = threadIdx.x, lane = tid & 63, wave = __builtin_amdgcn_readfirstlane(tid >> 6);
    const int c = blockIdx.x, G = gridDim.x, NGW = G * NWAVES; (void)lane; (void)wave;
    volatile LAS unsigned* misc = (volatile LAS unsigned*)(lds + LDS_MISC);
    if (tid < 64) misc[tid] = 0u;
    __syncthreads();
    unsigned* ctl = (unsigned*)(a.ws + WS_CTL);
    XcdBarrier bar = xcd_barrier_post(ctl + CW_BAR, misc + 8);

    for (int rep = 0; rep < REPK(0); ++rep) {
#if PH(0)
    { FRESH(t0, ln0, wv0, gw0) phase0(a, lds, t0, ln0, wv0, c, G); }
#endif
    xcd_barrier(bar);
    }

    bf16* const Hb = (bf16*)(a.ws + WS_H); bf16* const Ub = (bf16*)(a.ws + WS_U); bf16* const Qb = (bf16*)(a.ws + WS_Q); bf16* const Kb = (bf16*)(a.ws + WS_K); bf16* const Vb = (bf16*)(a.ws + WS_V);
    bf16* const GPb = (bf16*)(a.ws + WS_GP); bf16* const GAb = (bf16*)(a.ws + WS_GA); bf16* const PAb = (bf16*)(a.ws + WS_PA); bf16* const Tb = (bf16*)(a.ws + WS_T); bf16* const MGb = (bf16*)(a.ws + WS_MG); bf16* const UPb = (bf16*)(a.ws + WS_UP);
    const float* const modp = (const float*)(a.ws + WS_MOD);

    for (int l = 0; l < N_LAYERS_RUN; ++l) {
        const unsigned char* wl = a.ws + WS_W + (size_t)l * W_LAYER;
        for (int rep = 0; rep < REPK(1); ++rep) {
#if PH(1)
        { FRESH(t1, ln1, wv1, gw1) norm_phase(a, l, 0, ln1, gw1, NGW); }
#endif
        xcd_barrier(bar);
        }
        for (int rep = 0; rep < REPK(2); ++rep) {
        {
            pg8::Gemm g{Hb, (const bf16*)(wl + WO_IN), MROWS, INW, DM, DM, DM}; pg8::StaticOrder S; S.init(MROWS, INW, G, c);
            EpiIn E{Ub, Qb, Kb, Vb, GPb, GAb, a.in[I_QG] + l * 64, a.in[I_KG] + l * 64, (const float*)(a.ws + WS_ROPE), a.out, l};
#if PH(2)
            pg8::gemm_phase<EpiIn, pg8::StaticOrder, true, true>(lds, g, S, E);
#endif
#if PH(3)
            for (int r3 = 0; r3 < REPK(3); ++r3) { FRESH(t3, ln3, wv3, gw3) thin_in(a, lds, l, c, G, t3, wv3, ln3); }
#endif
        }
        xcd_barrier(bar);
        }
        for (int rep = 0; rep < REPK(5); ++rep) {
        {
#if PH(4)
            { FRESH(t4, ln4, wv4, gw4) for (int it = gw4; it < NB * 128 * 4; it += NGW) { const int gi = it & 3, run = it >> 2, b = run >> 7, t0 = (run & 127) * 32;
                if (gi == 0) pool_item<2>(Ub, PAb, b, t0, 0, ln4); else if (gi == 1) pool_item<4>(Ub, PAb, b, t0, 1, ln4); else if (gi == 2) pool_item<8>(Ub, PAb, b, t0, 2, ln4); else pool_item<16>(Ub, PAb, b, t0, 3, ln4); } }
#endif
#if PH(5)
            { FRESH(t5, ln5, wv5, gw5) for (int un = c; un < NB * 4 * 16; un += G) { const int pb = un & 15, j = (un >> 4) & 3, b = un >> 6;
                __syncthreads();
                attn_unit(lds, Qb, Kb, Vb, PAb, b, j, pb, wv5, ln5); } }
#endif
#if PH(6)
            { FRESH(t6, ln6, wv6, gw6) for (int it = c; it < SB * 4; it += G) sample_attn_wg(a, lds, l, it >> 2, it & 3, wv6, ln6); }
#endif
#if PH(7)
            { FRESH(t7, ln7, wv7, gw7) for (int it = NGW - 1 - gw7; it < SB; it += NGW) sample_pool_item(a, l, it, ln7); }
#endif
        }
        xcd_barrier(bar);
        }
        for (int rep = 0; rep < REPK(8); ++rep) {
        {
            pg8::Gemm g1{PAb, (const bf16*)(wl + WO_CAT), MROWS, DM, PW, AW, 768}; pg8::StaticOrder S; S.init(MROWS, DM, G, c);
            EpiEw<0> E1{GPb, nullptr, Tb, DM};
#if PH(8)
            pg8::gemm_phase<EpiEw<0>, pg8::StaticOrder, true, true>(lds, g1, S, E1);
#endif
            pg8::Gemm g2{PAb + PW, (const bf16*)(wl + WO_CAT) + PW, MROWS, DM, AO, AW, 768};
            EpiEw<1> E2{GAb, Tb, MGb, DM};
#if PH(9)
            pg8::gemm_phase<EpiEw<1>, pg8::StaticOrder, true, true>(lds, g2, S, E2);
#endif
#if PH(10)
            for (int r10 = 0; r10 < REPK(10); ++r10) { FRESH(t10, ln10, wv10, gw10) thin_gate(a, lds, l, c, G, t10, wv10, ln10); }
#endif
        }
        xcd_barrier(bar);
        }
        for (int rep = 0; rep < REPK(11); ++rep) {
            pg8::Gemm g{MGb, (const bf16*)(wl + WO_OUT), MROWS, DM, DM, DM, DM}; pg8::StaticOrder S; S.init(MROWS, DM, G, c);
            EpiRes E{l == 0 ? a.in[I_XP] : a.out + O_YP, rep == 0 ? a.out + O_YP : (float*)(a.ws + WS_UP), modp + (size_t)l * NMOD * MODW + 2 * DM};
#if PH(11)
            pg8::gemm_phase<EpiRes, pg8::StaticOrder, true, true>(lds, g, S, E);
#endif
#if PH(12)
            if (rep == 0) for (int r12 = 0; r12 < REPK(12); ++r12) { FRESH(t12, ln12, wv12, gw12) thin_res(a, lds, l, 0, c, G, t12, wv12, ln12, r12 != 0); }
#endif
            xcd_barrier(bar);
        }
        for (int rep = 0; rep < REPK(13); ++rep) {
#if PH(13)
        { FRESH(t13, ln13, wv13, gw13) norm_phase(a, l, 1, ln13, gw13, NGW); }
#endif
        xcd_barrier(bar);
        }
        for (int rep = 0; rep < REPK(14); ++rep) {
        {
            pg8::Gemm g{Hb, (const bf16*)(wl + WO_UP), MROWS, FF, DM, DM, DM}; pg8::StaticOrder S; S.init(MROWS, FF, G, c);
            EpiEw<2> E{nullptr, nullptr, UPb, FF};
#if PH(14)
            pg8::gemm_phase<EpiEw<2>, pg8::StaticOrder, true, true>(lds, g, S, E);
#endif
#if PH(15)
            for (int r15 = 0; r15 < REPK(15); ++r15) { FRESH(t15, ln15, wv15, gw15) thin_up(a, lds, l, c, G, t15, wv15, ln15); }
#endif
        }
        xcd_barrier(bar);
        }
        for (int rep = 0; rep < REPK(16); ++rep) {
            pg8::Gemm g{UPb, (const bf16*)(wl + WO_DN), MROWS, DM, FF, FF, FF}; pg8::StaticOrder S; S.init(MROWS, DM, G, c);
            EpiRes E{a.out + O_YP, rep == 0 ? a.out + O_YP : (float*)(a.ws + WS_GP), modp + (size_t)l * NMOD * MODW + 5 * DM};
#if PH(16)
            pg8::gemm_phase<EpiRes, pg8::StaticOrder, true, true>(lds, g, S, E);
#endif
#if PH(17)
            if (rep == 0) for (int r17 = 0; r17 < REPK(17); ++r17) { FRESH(t17, ln17, wv17, gw17) thin_res(a, lds, l, 1, c, G, t17, wv17, ln17, r17 != 0); }
#endif
            xcd_barrier(bar);
        }
    }
    if (__hip_atomic_load(ctl + CW_BAR + XB_TMO, __ATOMIC_RELAXED, __HIP_MEMORY_SCOPE_AGENT) != 0u) {
        const float qn = __builtin_nanf("");
        for (int i = c * NTHREADS + tid; i < SB * DM; i += G * NTHREADS) a.out[O_YS + i] = qn;
    }
}

extern "C" void kernel_launch(void* const* d_in, const int* in_sizes, int n_in, void* d_out, int out_size, void* d_ws, size_t ws_size, hipStream_t stream) {
    static int grid = 0;
    if (grid == 0) {
        if (n_in != N_IN || (size_t)out_size != O_END || ws_size < WS_END) { fprintf(stderr, "kernel_launch: unexpected shapes: n_in %d out %d ws %zu; nothing launched\n", n_in, out_size, ws_size); grid = -1; return; }
        int dev = 0, cus = 0, per_cu = 0;
        if (hipGetDevice(&dev) != hipSuccess || hipDeviceGetAttribute(&cus, hipDeviceAttributeMultiprocessorCount, dev) != hipSuccess) { fprintf(stderr, "kernel_launch: device query failed\n"); grid = -1; return; }
        if (hipFuncSetAttribute((const void*)fwd, hipFuncAttributeMaxDynamicSharedMemorySize, LDS_BYTES) != hipSuccess) { fprintf(stderr, "kernel_launch: hipFuncSetAttribute failed\n"); grid = -1; return; }
        if (hipOccupancyMaxActiveBlocksPerMultiprocessor(&per_cu, (const void*)fwd, NTHREADS, LDS_BYTES) != hipSuccess || per_cu < 1) fprintf(stderr, "kernel_launch: note: occupancy query reports %d workgroups per CU\n", per_cu);
        (void)hipGetLastError();
        grid = cus;
    }
    if (grid < 0) return;
    if (hipMemsetAsync((char*)d_ws + WS_CTL, 0, CTL_ZERO_BYTES, stream) != hipSuccess) { fprintf(stderr, "kernel_launch: memset failed\n"); return; }
    Args a{};
    for (int i = 0; i < N_IN; ++i) a.in[i] = (const float*)d_in[i];
    a.out = (float*)d_out; a.ws = (unsigned char*)d_ws;
    hipLaunchKernelGGL(fwd, dim3(grid), dim3(NTHREADS), LDS_BYTES, stream, a);
    const hipError_t le = hipPeekAtLastError();
    if (le != hipSuccess) fprintf(stderr, "kernel_launch: launch failed: %s\n", hipGetErrorName(le));
}
```
